# Optimizing an MI355X kernel written in HIP

```python
import jax, jax.numpy as jnp
from jax import lax
import numpy as np

D_MODEL = 2048
BATCH = 4
SEQ = 4096
DEPTH = 1

MIX_WIDTH = D_MODEL
CONV_WIDTH = MIX_WIDTH // 2
CONV_GROUPS = 8
CONV_K = 3
DN_HEADS = 8
DN_HEAD_DIM = 128
DN_WIDTH = DN_HEADS * DN_HEAD_DIM
DN_CONV_K = 4
CHUNK = 64
D_FF = 5632
FFN_CONV_K = 3
PLE_DIM = 256
EPS = 1e-6
IN_COLS = 3 * CONV_WIDTH + 4 * DN_WIDTH + 2 * DN_HEADS

kernel_name = "hybrid_shortconv_gated_deltanet_convffn_ple"


def rmsnorm(x, g):
    xf = x.astype(jnp.float32)
    y = xf * lax.rsqrt(jnp.mean(xf * xf, axis=-1, keepdims=True) + EPS) * g.astype(jnp.float32)
    return y.astype(x.dtype)


def causal_dwconv(x, w):
    K = w.shape[0]
    S = x.shape[1]
    xp = jnp.pad(x, ((0, 0), (K - 1, 0), (0, 0)))
    y = xp[:, 0:S] * w[0]
    for j in range(1, K):
        y = y + xp[:, j:j + S] * w[j]
    return y


def l2norm(x):
    return x * lax.rsqrt(jnp.sum(x * x, axis=-1, keepdims=True) + EPS)


def chunk_gated_delta(q, k, v, g, beta):
    B, H, S, dk = q.shape
    dv = v.shape[-1]
    N = S // CHUNK
    q = q * (dk ** -0.5)
    qc = q.reshape(B, H, N, CHUNK, dk)
    kc = k.reshape(B, H, N, CHUNK, dk)
    vc = v.reshape(B, H, N, CHUNK, dv)
    bc = beta.reshape(B, H, N, CHUNK)
    gcum = jnp.cumsum(g.reshape(B, H, N, CHUNK), axis=-1)
    idx = jnp.arange(CHUNK)
    causal = idx[:, None] >= idx[None, :]
    strict = idx[:, None] > idx[None, :]
    diff = gcum[..., :, None] - gcum[..., None, :]
    decay = jnp.exp(jnp.where(causal, diff, -jnp.inf))
    kk = jnp.einsum('bhncd,bhnmd->bhncm', kc, kc)
    L = jnp.where(strict, kk * decay * bc[..., :, None], 0.0)
    A = L + jnp.eye(CHUNK, dtype=jnp.float32)
    rhs = jnp.concatenate([vc * bc[..., None],
                           kc * (bc * jnp.exp(gcum))[..., None]], axis=-1)
    sol = lax.linalg.triangular_solve(A, rhs, left_side=True, lower=True)
    u = sol[..., :dv]
    w = sol[..., dv:]
    qk = jnp.einsum('bhncd,bhnmd->bhncm', qc, kc) * decay
    q_dec = qc * jnp.exp(gcum)[..., None]
    k_dec = kc * jnp.exp(gcum[..., -1:] - gcum)[..., None]
    g_last = jnp.exp(gcum[..., -1])

    def step(state, inp):
        u_n, w_n, qk_n, qd_n, kd_n, gl_n = inp
        v_new = u_n - jnp.einsum('bhcd,bhde->bhce', w_n, state)
        o = (jnp.einsum('bhcd,bhde->bhce', qd_n, state)
             + jnp.einsum('bhcm,bhme->bhce', qk_n, v_new))
        state = state * gl_n[..., None, None] + jnp.einsum('bhcd,bhce->bhde', kd_n, v_new)
        return state, o

    to_front = lambda t: jnp.moveaxis(t, 2, 0)
    xs = (to_front(u), to_front(w), to_front(qk), to_front(q_dec), to_front(k_dec),
          jnp.moveaxis(g_last, 2, 0))
    s0 = jnp.zeros((B, H, dk, dv), jnp.float32)
    _, o = lax.scan(step, s0, xs)
    return jnp.moveaxis(o, 0, 2).reshape(B, H, S, dv)


def hybrid_layer(x, p_i, norm_mix_g, w_in, conv_a_w, conv_qkv_w, a_log, dt_bias, dn_norm_g,
                 w_out, norm_ffn_g, w_up, conv_ffn_w, w_down, norm_ple_g, w_ple_gate, w_ple_proj):
    Bsz, S, _ = x.shape
    h = rmsnorm(x, norm_mix_g)
    proj = h @ w_in
    s1 = CONV_WIDTH
    s2 = 2 * CONV_WIDTH
    s3 = 3 * CONV_WIDTH
    s4 = s3 + 3 * DN_WIDTH
    s5 = s4 + DN_WIDTH
    s6 = s5 + DN_HEADS
    a_x, a_b, a_c, qkv, z, a_dec, b_beta = jnp.split(proj, [s1, s2, s3, s4, s5, s6], axis=-1)

    y_a = a_b * causal_dwconv(a_c * a_x, conv_a_w)

    qkv = jax.nn.silu(causal_dwconv(qkv, conv_qkv_w)).astype(jnp.float32)
    q, k, v = jnp.split(qkv, 3, axis=-1)
    q = l2norm(q.reshape(Bsz, S, DN_HEADS, DN_HEAD_DIM))
    k = l2norm(k.reshape(Bsz, S, DN_HEADS, DN_HEAD_DIM))
    v = v.reshape(Bsz, S, DN_HEADS, DN_HEAD_DIM)
    g = -jnp.exp(a_log.astype(jnp.float32)) * jax.nn.softplus(
        a_dec.astype(jnp.float32) + dt_bias.astype(jnp.float32))
    beta = jax.nn.sigmoid(b_beta.astype(jnp.float32))
    tr = lambda t: jnp.swapaxes(t, 1, 2)
    o = chunk_gated_delta(tr(q), tr(k), tr(v), tr(g), tr(beta))
    o = tr(o)
    zf = z.astype(jnp.float32).reshape(Bsz, S, DN_HEADS, DN_HEAD_DIM)
    o = (o * lax.rsqrt(jnp.mean(o * o, axis=-1, keepdims=True) + EPS)
         * dn_norm_g.astype(jnp.float32) * jax.nn.silu(zf))
    y_b = o.reshape(Bsz, S, DN_WIDTH).astype(x.dtype)

    x = x + jnp.concatenate([y_a, y_b], axis=-1) @ w_out

    h = rmsnorm(x, norm_ffn_g)
    up = causal_dwconv(h @ w_up, conv_ffn_w)
    gate, val = jnp.split(up, 2, axis=-1)
    x = x + (jax.nn.silu(gate) * val) @ w_down

    ple_gate = jax.nn.sigmoid(rmsnorm(x, norm_ple_g) @ w_ple_gate)
    x = x + ple_gate * (p_i @ w_ple_proj)
    return x


def setup_inputs(seed: int = 0) -> dict:
    key = jax.random.key(seed)
    ks = jax.random.split(key, 20)
    f32 = jnp.float32
    nrm = lambda k, shape, scale: jax.random.normal(k, shape, f32) * scale
    gain = lambda k, shape: 1.0 + 0.02 * jax.random.normal(k, shape, f32)
    return {
        "x": jax.random.normal(ks[0], (BATCH, SEQ, D_MODEL), f32),
        "p": jax.random.normal(ks[1], (DEPTH, BATCH, SEQ, PLE_DIM), f32),
        "norm_mix_g": gain(ks[2], (DEPTH, D_MODEL)),
        "w_in": nrm(ks[3], (DEPTH, D_MODEL, IN_COLS), D_MODEL ** -0.5),
        "conv_a_w": nrm(ks[4], (DEPTH, CONV_K, CONV_WIDTH), CONV_K ** -0.5),
        "conv_qkv_w": nrm(ks[5], (DEPTH, DN_CONV_K, 3 * DN_WIDTH), DN_CONV_K ** -0.5),
        "a_log": jnp.log(jax.random.uniform(ks[6], (DEPTH, DN_HEADS), f32, 1.0, 16.0)),
        "dt_bias": 0.1 * jax.random.normal(ks[7], (DEPTH, DN_HEADS), f32),
        "dn_norm_g": gain(ks[8], (DEPTH, DN_HEAD_DIM)),
        "w_out": nrm(ks[9], (DEPTH, MIX_WIDTH, D_MODEL), MIX_WIDTH ** -0.5),
        "norm_ffn_g": gain(ks[10], (DEPTH, D_MODEL)),
        "w_up": nrm(ks[11], (DEPTH, D_MODEL, 2 * D_FF), D_MODEL ** -0.5),
        "conv_ffn_w": nrm(ks[12], (DEPTH, FFN_CONV_K, 2 * D_FF), FFN_CONV_K ** -0.5),
        "w_down": nrm(ks[13], (DEPTH, D_FF, D_MODEL), D_FF ** -0.5),
        "norm_ple_g": gain(ks[14], (DEPTH, D_MODEL)),
        "w_ple_gate": nrm(ks[15], (DEPTH, D_MODEL, D_MODEL), D_MODEL ** -0.5),
        "w_ple_proj": nrm(ks[16], (DEPTH, PLE_DIM, D_MODEL), PLE_DIM ** -0.5),
        "final_norm_g": gain(ks[17], (D_MODEL,)),
    }


def reference(x, p, norm_mix_g, w_in, conv_a_w, conv_qkv_w, a_log, dt_bias, dn_norm_g,
              w_out, norm_ffn_g, w_up, conv_ffn_w, w_down, norm_ple_g, w_ple_gate,
              w_ple_proj, final_norm_g):
    for i in range(DEPTH):
        x = hybrid_layer(x, p[i], norm_mix_g[i], w_in[i], conv_a_w[i], conv_qkv_w[i],
                         a_log[i], dt_bias[i], dn_norm_g[i], w_out[i], norm_ffn_g[i],
                         w_up[i], conv_ffn_w[i], w_down[i], norm_ple_g[i], w_ple_gate[i],
                         w_ple_proj[i])
    return rmsnorm(x, final_norm_g)
```

```cpp
#include <hip/hip_runtime.h>
#include <hip/hip_cooperative_groups.h>
#include <cstdio>
namespace cg = cooperative_groups;

#define LAS __attribute__((address_space(3)))
typedef unsigned short bf16_t;
typedef short bf16x8 __attribute__((ext_vector_type(8)));
typedef float f32x4 __attribute__((ext_vector_type(4)));
typedef unsigned u32x4 __attribute__((ext_vector_type(4)));
typedef unsigned u32x2 __attribute__((ext_vector_type(2)));

constexpr int T_ = 16384, D_ = 2048, SEQ_ = 4096, NPROJ = 7168, INCOLS = 7184, HD = 128, DFF = 5632, NUP = 11264, PLE_ = 256, NCHUNK = 2048;
constexpr float EPS_ = 1e-6f;
constexpr int LDS_BYTES = 147456;
constexpr int NPHASE = 11;

constexpr size_t WS_WIN = 0;
constexpr size_t WS_WAB = WS_WIN + (size_t)NPROJ * D_ * 2;
constexpr size_t WS_WOUT = WS_WAB + 16 * D_ * 2;
constexpr size_t WS_B = WS_WOUT + (size_t)D_ * D_ * 2;
constexpr size_t WS_PROJ = WS_B + (size_t)T_ * D_ * 2;
constexpr size_t WS_ACT = WS_PROJ;
constexpr size_t WS_X3B = WS_PROJ;
constexpr size_t WS_EDGE = WS_ACT + (size_t)T_ * DFF * 2;
constexpr size_t WS_D = WS_PROJ + (size_t)T_ * NPROJ * 2;
constexpr size_t CH16 = (size_t)NCHUNK * 64 * 128 * 2;
constexpr size_t WS_U = WS_D;
constexpr size_t WS_W = WS_U + CH16;
constexpr size_t WS_QD = WS_W + CH16;
constexpr size_t WS_KDT = WS_QD + CH16;
constexpr size_t WS_QK = WS_KDT + CH16;
constexpr size_t WS_O = WS_QK + (size_t)NCHUNK * 64 * 64 * 2;
constexpr size_t WS_DEND = WS_O + (size_t)T_ * 1024 * 2;
constexpr size_t WS_YCAT = WS_D;
constexpr size_t WS_PP = WS_D;
constexpr size_t WS_X1B = WS_D + (size_t)T_ * D_ * 2;
constexpr size_t WS_WUP = WS_B;
constexpr size_t WS_WPG = WS_WUP + (size_t)NUP * D_ * 2;
constexpr size_t WS_LATE_END = WS_WPG + (size_t)D_ * D_ * 2;
constexpr size_t WS_WDOWN = WS_WIN;
static_assert(WS_LATE_END <= WS_PROJ, "late weights overflow region B");
static_assert((size_t)D_ * DFF * 2 <= (size_t)NPROJ * D_ * 2, "w_down copy overflow");
static_assert(WS_X1B + (size_t)T_ * D_ * 2 <= WS_O, "x1b overlaps O");
static_assert(WS_EDGE + (size_t)256 * 4 * NUP * 4 <= WS_D, "edge overflow");
constexpr size_t WS_AB = WS_DEND;
constexpr size_t WS_RSS = WS_AB + (size_t)T_ * 16 * 4;
constexpr size_t WS_PB = WS_RSS + (size_t)3 * T_ * 4;
constexpr size_t WS_GL = WS_PB + (size_t)T_ * PLE_ * 2;
constexpr size_t WS_BAR = WS_GL + NCHUNK * 4;
constexpr int XCD_BAR_WORDS = 3456;
constexpr size_t WS_WPP = (WS_BAR + (size_t)XCD_BAR_WORDS * 4 + 255) / 256 * 256;
constexpr size_t WS_END = WS_WPP + (size_t)D_ * PLE_ * 2;
static_assert(WS_END <= (size_t)512 * 1024 * 1024, "workspace exceeds 512 MiB");

struct Args { const float* in[18]; float* out; unsigned char* ws; int ph_lo, ph_hi; };

typedef __bf16 bf16x2_t __attribute__((ext_vector_type(2)));
typedef float f32x2_t __attribute__((ext_vector_type(2)));
__device__ __forceinline__ unsigned pk2(float lo, float hi) { f32x2_t v = {lo, hi}; bf16x2_t b = __builtin_convertvector(v, bf16x2_t); return __builtin_bit_cast(unsigned, b); }
__device__ __forceinline__ bf16_t f2b(float x) { return (bf16_t)(pk2(x, 0.f) & 0xffffu); }
__device__ __forceinline__ float b2f(bf16_t v) { return __uint_as_float((unsigned)v << 16); }
__device__ __forceinline__ float blo(unsigned v) { return __uint_as_float(v << 16); }
__device__ __forceinline__ float bhi(unsigned v) { return __uint_as_float(v & 0xffff0000u); }
__device__ __forceinline__ float silu_f(float x) { return x * __builtin_amdgcn_rcpf(1.f + __expf(-x)); }
__device__ __forceinline__ float sigmoid_f(float x) { return __builtin_amdgcn_rcpf(1.f + __expf(-x)); }
template <int CTRL> __device__ __forceinline__ float dpp_rot(float v) { return __int_as_float(__builtin_amdgcn_mov_dpp(__float_as_int(v), CTRL, 0xF, 0xF, true)); }
template <int CTRL, int ROWMASK> __device__ __forceinline__ float dpp_f(float v) { return __int_as_float(__builtin_amdgcn_update_dpp(0, __float_as_int(v), CTRL, ROWMASK, 0xF, false)); }
__device__ __forceinline__ float wave_sum(float v) {
    v += dpp_rot<0xB1>(v); v += dpp_rot<0x4E>(v); v += dpp_rot<0x141>(v); v += dpp_rot<0x140>(v);
    v += dpp_f<0x142, 0xA>(v); v += dpp_f<0x143, 0xC>(v);
    return __int_as_float(__builtin_amdgcn_readlane(__float_as_int(v), 63));
}
__device__ __forceinline__ int lane_opaque() { int l; asm volatile("v_mbcnt_lo_u32_b32 %0, -1, 0\n\tv_mbcnt_hi_u32_b32 %0, -1, %0" : "=v"(l)); return l; }
#define TID_SETUP const int lane = lane_opaque(); const int tid = wave_s * 64 + lane; const int wave = wave_s; (void)wave; (void)lane
__device__ __forceinline__ float bperm(float v, int byteaddr) { return __int_as_float(__builtin_amdgcn_ds_bpermute(byteaddr, __float_as_int(v))); }
#define LDS_WAIT() asm volatile("s_waitcnt lgkmcnt(0)" ::: "memory")


#define XB_TMO      128
#define XB_XCNT(j)  (256  + 64 * (j))
#define XB_XSUB(j)  (1280 + 64 * (j))
#define XB_XGEN(j)  (2304 + 64 * (j))
#define XB_TOP      3328
#define XB_TOPGEN   3392
#define XB_SPIN_CAP (1u << 22)
__device__ __forceinline__ unsigned xb_ld(unsigned* p)              { return __hip_atomic_load(p, __ATOMIC_RELAXED, __HIP_MEMORY_SCOPE_AGENT); }
__device__ __forceinline__ unsigned xb_add(unsigned* p, unsigned v) { return __hip_atomic_fetch_add(p, v, __ATOMIC_RELAXED, __HIP_MEMORY_SCOPE_AGENT); }
__device__ __forceinline__ unsigned xb_xcc_id() { return (unsigned)__builtin_amdgcn_s_getreg((3 << 11) | 20) & 0xFu; }
#define XB_SPIN(cond, bar) do { unsigned _sp = 0; while (cond) { __builtin_amdgcn_s_sleep(1); \
    if ((++_sp & 255u) == 0u) { if (xb_ld(&(bar)[XB_TMO])) break; if (_sp > XB_SPIN_CAP) { atomicAdd(&(bar)[XB_TMO], 1u); break; } } } } while (0)
__device__ __forceinline__ void xcd_barrier_complete(unsigned* bar, unsigned x, unsigned& nloc, unsigned& nx) {
    const unsigned G = gridDim.x;
    unsigned sum, cnt, mine, sp = 0u;
    for (;;) {
        sum = 0u; cnt = 0u; mine = 0u;
#pragma unroll
        for (unsigned j = 0; j < 16; ++j) { const unsigned c = xb_ld(&bar[XB_XCNT(j)]); sum += c; cnt += (c > 0u) ? 1u : 0u; mine = (j == x) ? c : mine; }
        if (sum == G) break;
        __builtin_amdgcn_s_sleep(1);
        if ((++sp & 255u) == 0u) { if (xb_ld(&bar[XB_TMO])) break; if (sp > XB_SPIN_CAP) { atomicAdd(&bar[XB_TMO], 1u); break; } }
    }
    nloc = mine > 0u ? mine : 1u; nx = cnt > 0u ? cnt : 1u;
}
__device__ __forceinline__ void xcd_barrier(unsigned* bar, volatile LAS unsigned* st, const bool leader) {
    asm volatile("s_waitcnt vmcnt(0)" ::: "memory");
    __syncthreads();
    if (leader) {
        const unsigned x = xb_xcc_id();
        __builtin_amdgcn_s_waitcnt(0);
        unsigned nloc = st[0], nx = st[1];
        if (nloc == 0u) { xcd_barrier_complete(bar, x, nloc, nx); st[0] = nloc; st[1] = nx; }
        const unsigned old = xb_add(&bar[XB_XSUB(x)], 1u);
        const unsigned gen = old / nloc;
        if (old + 1u == (gen + 1u) * nloc) {
            __builtin_amdgcn_fence(__ATOMIC_RELEASE, "agent");
            asm volatile("s_waitcnt vmcnt(0)" ::: "memory");
            const unsigned og = xb_add(&bar[XB_TOP], 1u);
            const unsigned tg = og / nx;
            if (og + 1u == (tg + 1u) * nx) xb_add(&bar[XB_TOPGEN], 1u);
            else XB_SPIN(xb_ld(&bar[XB_TOPGEN]) == tg, bar);
            __builtin_amdgcn_fence(__ATOMIC_ACQUIRE, "agent");
            xb_add(&bar[XB_XGEN(x)], 1u);
            asm volatile("s_waitcnt vmcnt(0)" ::: "memory");
        } else {
            XB_SPIN(xb_ld(&bar[XB_XGEN(x)]) == gen, bar);
            __builtin_amdgcn_fence(__ATOMIC_ACQUIRE, "agent");
            asm volatile("s_waitcnt vmcnt(0)" ::: "memory");
        }
    }
    __syncthreads();
}

namespace pg8 {
constexpr int BM = 256, BK = 64, HALF = 128, HTB = HALF * BK * 2, STAGE_BYTES = 8 * HTB, NXCD = 8, WGM = 8;
__host__ __device__ __forceinline__ int lds_byte(int r, int c) { const int st = (r >> 4) * 2 + (c >> 5), rr = r & 15, cc = c & 31, ob = rr * 64 + cc * 2; return st * 1024 + (ob ^ (((ob >> 9) & 1) << 5)); }
__host__ __device__ __forceinline__ void stage_rc(int b, int& R, int& C) { const int st = b / 1024, sb = b % 1024, swz = sb ^ (((sb >> 9) & 1) << 5); R = (st >> 1) * 16 + swz / 64; C = (st & 1) * 32 + (swz % 64) / 2; }
__host__ __device__ __forceinline__ int perm32(int rho) { const int n = rho >> 4, i = rho & 15; return 8 * (i >> 2) + 4 * n + (i & 3); }
struct Unit { int pm, pn; };
struct Gemm { const bf16_t* A; const bf16_t* Bt; int M, N, K; };
struct StaticOrder {
    int nM, nN, nwg, G, c;
    __host__ __device__ void init(int M, int N, int G_, int c_) { nM = M / BM; nN = N / BM; nwg = nM * nN; G = G_; c = c_; }
    __host__ __device__ bool next(int i, Unit& u) const {
        const long L = (long)i * G + c; if (L >= nwg) return false;
        int wgid = (int)L; { const int q = nwg / NXCD, r = nwg % NXCD, xcd = wgid % NXCD, off = wgid / NXCD; wgid = (xcd < r ? xcd * (q + 1) : r * (q + 1) + (xcd - r) * q) + off; }
        const int nig = WGM * nN, gid = wgid / nig, fm = gid * WGM, gsz = (nM - fm) < WGM ? (nM - fm) : WGM;
        u.pm = fm + ((wgid % nig) % gsz); u.pn = (wgid % nig) / gsz; return true;
    }
};
template <class Epi>
__device__ __forceinline__ void gemm_phase(LAS unsigned char* lds, const Gemm g, const StaticOrder& S, const Epi& E, const int wave_s) {
    const int lane = lane_opaque(), tid = wave_s * 64 + lane, wid = wave_s, wr = wid >> 2, wc = wid & 3, fr = lane & 15, fq = lane >> 4;
    const int K = g.K, nt = K / BK;
    unsigned voffA[2], voffB[2];
#pragma unroll
    for (int i = 0; i < 2; ++i) { int R, C; stage_rc(tid * 16 + i * 8192, R, C); const int Rb = Epi::PERM ? ((R & ~31) + perm32(R & 31)) : R;
        const int Ra = Epi::PERM_A ? ((R & ~63) + 4 * (R & 15) + ((R >> 4) & 3)) : R;
        voffA[i] = (unsigned)(Ra * K + C) * 2u; voffB[i] = (unsigned)(Rb * K + C) * 2u; }
    const size_t kstep = (size_t)(BK * 2);
    const size_t hstep = (size_t)HALF * K * 2;
    const size_t tstep = 2 * hstep;
    const unsigned ldsw = (unsigned)wid * 1024u;
    const int aoff = lds_byte(wr * 64 + fr, fq * 8), boff = lds_byte(wc * 32 + fr, fq * 8);
#define PG8_SA(b, h) (((b) * 2 + (h)) * HTB)
#define PG8_SB(b, h) ((4 + (b) * 2 + (h)) * HTB)
#define PG8_STAGE(bufoff, gbase, voff) do { _Pragma("unroll") for (int _i = 0; _i < 2; ++_i) \
        __builtin_amdgcn_global_load_lds((const unsigned*)((const char*)(gbase) + (voff)[_i]), (LAS unsigned*)(lds + (bufoff) + ldsw + _i * 8192), 16, 0, 0); } while (0)
#define PG8_LDA(dst, b, h) do { _Pragma("unroll") for (int m = 0; m < 4; ++m) _Pragma("unroll") for (int k = 0; k < 2; ++k) dst[m][k] = *(const LAS bf16x8*)(lds + PG8_SA(b, h) + aoff + m * 2048 + k * 1024); } while (0)
#define PG8_LDB(dst, b, h) do { _Pragma("unroll") for (int n = 0; n < 2; ++n) _Pragma("unroll") for (int k = 0; k < 2; ++k) dst[n][k] = *(const LAS bf16x8*)(lds + PG8_SB(b, h) + boff + n * 2048 + k * 1024); } while (0)
#define PG8_MMA(ai, bj, At, Bt) do { __builtin_amdgcn_s_setprio(1); _Pragma("unroll") for (int m = 0; m < 4; ++m) _Pragma("unroll") for (int n = 0; n < 2; ++n) _Pragma("unroll") for (int k = 0; k < 2; ++k) \
        acc[ai][bj][m][n] = __builtin_amdgcn_mfma_f32_16x16x32_bf16(Bt[n][k], At[m][k], acc[ai][bj][m][n], 0, 0, 0); __builtin_amdgcn_s_setprio(0); } while (0)
#define PG8_WAIT_V(n) asm volatile("s_waitcnt vmcnt(" #n ")" ::: "memory")
#define PG8_WAIT_L(n) asm volatile("s_waitcnt lgkmcnt(" #n ")" ::: "memory")
#define PG8_BAR __builtin_amdgcn_s_barrier()
#define PG8_SCHED __builtin_amdgcn_sched_barrier(0)
    Unit cur, nxt; int ui = 0;
    if (!S.next(0, cur)) return;
    f32x4 acc[2][2][4][2];
#pragma unroll
    for (int a = 0; a < 2; ++a)
#pragma unroll
        for (int b = 0; b < 2; ++b)
#pragma unroll
            for (int m = 0; m < 4; ++m)
#pragma unroll
                for (int n = 0; n < 2; ++n) acc[a][b][m][n] = (f32x4){0.f, 0.f, 0.f, 0.f};
    bf16x8 At[4][2], B0[2][2], B1[2][2];
    const char* cA = (const char*)g.A + (size_t)cur.pm * tstep; const char* cB = (const char*)g.Bt + (size_t)cur.pn * tstep;
    PG8_STAGE(PG8_SB(0, 0), cB, voffB); PG8_STAGE(PG8_SA(0, 0), cA, voffA); PG8_STAGE(PG8_SB(0, 1), cB + hstep, voffB); PG8_STAGE(PG8_SA(0, 1), cA + hstep, voffA);
    if (wr == 1) PG8_BAR;
    PG8_WAIT_V(4); PG8_BAR;
    PG8_STAGE(PG8_SB(1, 0), cB + kstep, voffB); PG8_STAGE(PG8_SA(1, 0), cA + kstep, voffA); PG8_STAGE(PG8_SB(1, 1), cB + hstep + kstep, voffB);
    PG8_WAIT_V(6); PG8_BAR;
    for (;;) {
        const bool has_next = S.next(ui + 1, nxt);
        const char* nA = has_next ? (const char*)g.A + (size_t)nxt.pm * tstep : cA; const char* nB = has_next ? (const char*)g.Bt + (size_t)nxt.pn * tstep : cB;
        for (int t = 0; t < nt; t += 2) {
            const bool last = (t == nt - 2);
            const char* a1 = cA + (size_t)(t + 1) * kstep;
            const char* a2 = last ? nA : cA + (size_t)(t + 2) * kstep; const char* b2 = last ? nB : cB + (size_t)(t + 2) * kstep;
            const char* a3 = a2 + kstep; const char* b3 = b2 + kstep;
            PG8_LDB(B0, 0, 0); PG8_SCHED; PG8_LDA(At, 0, 0); PG8_STAGE(PG8_SA(1, 1), a1 + hstep, voffA);
            PG8_WAIT_L(8); PG8_BAR; PG8_WAIT_L(0); PG8_MMA(0, 0, At, B0); PG8_BAR; PG8_SCHED;
            PG8_LDB(B1, 0, 1); PG8_STAGE(PG8_SB(0, 0), b2, voffB);
            PG8_BAR; PG8_WAIT_L(0); PG8_MMA(0, 1, At, B1); PG8_BAR;
            PG8_LDA(At, 0, 1); PG8_STAGE(PG8_SA(0, 0), a2, voffA);
            PG8_BAR; PG8_WAIT_L(0); PG8_MMA(1, 0, At, B0); PG8_BAR; PG8_SCHED;
            PG8_STAGE(PG8_SB(0, 1), b2 + hstep, voffB);
            PG8_WAIT_V(6); PG8_BAR; PG8_MMA(1, 1, At, B1); PG8_BAR;
            PG8_LDB(B0, 1, 0); PG8_SCHED; PG8_LDA(At, 1, 0); PG8_STAGE(PG8_SA(0, 1), a2 + hstep, voffA);
            PG8_WAIT_L(8); PG8_BAR; PG8_WAIT_L(0); PG8_MMA(0, 0, At, B0); PG8_BAR; PG8_SCHED;
            PG8_LDB(B1, 1, 1); PG8_STAGE(PG8_SB(1, 0), b3, voffB);
            PG8_BAR; PG8_WAIT_L(0); PG8_MMA(0, 1, At, B1); PG8_BAR;
            PG8_LDA(At, 1, 1); PG8_STAGE(PG8_SA(1, 0), a3, voffA);
            PG8_BAR; PG8_WAIT_L(0); PG8_MMA(1, 0, At, B0); PG8_BAR; PG8_SCHED;
            PG8_STAGE(PG8_SB(1, 1), b3 + hstep, voffB);
            PG8_WAIT_V(6); PG8_BAR; PG8_MMA(1, 1, At, B1); PG8_BAR;
        }
        E(acc, cur, wr, wc, fr, fq);
        if (!has_next) break;
#pragma unroll
        for (int a = 0; a < 2; ++a)
#pragma unroll
            for (int b = 0; b < 2; ++b)
#pragma unroll
                for (int m = 0; m < 4; ++m)
#pragma unroll
                    for (int n = 0; n < 2; ++n) acc[a][b][m][n] = (f32x4){0.f, 0.f, 0.f, 0.f};
        cur = nxt; cA = nA; cB = nB; ++ui;
    }
    PG8_WAIT_V(0);
    if (wr == 0) PG8_BAR;
    PG8_BAR;
#undef PG8_SA
#undef PG8_SB
#undef PG8_STAGE
#undef PG8_LDA
#undef PG8_LDB
#undef PG8_MMA
#undef PG8_WAIT_V
#undef PG8_WAIT_L
#undef PG8_BAR
#undef PG8_SCHED
}
}
using pg8::Unit;
typedef const f32x4 (&AccRef)[2][2][4][2];

struct EpiBf16Store {
    static constexpr bool PERM = true, PERM_A = false;
    bf16_t* O; int ldc;
    __device__ __forceinline__ void operator()(AccRef acc, const Unit& u, int wr, int wc, int fr, int fq) const {
        { const int l_ = lane_opaque(); fr = l_ & 15; fq = l_ >> 4; }
        const int row0 = u.pm * 256 + wr * 64 + fr, col0 = u.pn * 256 + wc * 32 + 8 * fq;
#pragma unroll
        for (int ai = 0; ai < 2; ++ai)
#pragma unroll
            for (int m = 0; m < 4; ++m) { bf16_t* rowp = O + (size_t)(row0 + ai * 128 + m * 16) * ldc + col0;
#pragma unroll
                for (int bj = 0; bj < 2; ++bj) { const f32x4 v0 = acc[ai][bj][m][0], v1 = acc[ai][bj][m][1];
                    u32x4 w; w.x = pk2(v0[0], v0[1]); w.y = pk2(v0[2], v0[3]); w.z = pk2(v1[0], v1[1]); w.w = pk2(v1[2], v1[3]); *(u32x4*)(rowp + bj * 128) = w; } }
    }
};
template <bool RES_BF16> struct EpiResidual {
    static constexpr bool PERM = true, PERM_A = false;
    const float* resf; const bf16_t* resb; bf16_t* outb; float* rss;
    __device__ __forceinline__ void operator()(AccRef acc, const Unit& u, int wr, int wc, int fr, int fq) const {
        { const int l_ = lane_opaque(); fr = l_ & 15; fq = l_ >> 4; }
        const int row0 = u.pm * 256 + wr * 64 + fr, col0 = u.pn * 256 + wc * 32 + 8 * fq;
#pragma unroll
        for (int ai = 0; ai < 2; ++ai) {
            u32x4 rb[4][2]; f32x4 rf[4][2][2];
#pragma unroll
            for (int m = 0; m < 4; ++m)
#pragma unroll
                for (int bj = 0; bj < 2; ++bj) { const size_t o = (size_t)(row0 + ai * 128 + m * 16) * D_ + col0 + bj * 128;
                    if (RES_BF16) rb[m][bj] = *(const u32x4*)(resb + o); else { rf[m][bj][0] = *(const f32x4*)(resf + o); rf[m][bj][1] = *(const f32x4*)(resf + o + 4); } }
            __builtin_amdgcn_sched_barrier(0);
#pragma unroll
            for (int m = 0; m < 4; ++m) { const int row = row0 + ai * 128 + m * 16; const size_t ro = (size_t)row * D_ + col0; float ss = 0.f;
#pragma unroll
                for (int bj = 0; bj < 2; ++bj) { const size_t o = ro + bj * 128; f32x4 r0, r1;
                    if (RES_BF16) { const u32x4 rw = rb[m][bj]; r0[0] = blo(rw.x); r0[1] = bhi(rw.x); r0[2] = blo(rw.y); r0[3] = bhi(rw.y); r1[0] = blo(rw.z); r1[1] = bhi(rw.z); r1[2] = blo(rw.w); r1[3] = bhi(rw.w); }
                    else { r0 = rf[m][bj][0]; r1 = rf[m][bj][1]; }
                    const f32x4 v0 = acc[ai][bj][m][0] + r0, v1 = acc[ai][bj][m][1] + r1;
                    u32x4 w; w.x = pk2(v0[0], v0[1]); w.y = pk2(v0[2], v0[3]); w.z = pk2(v1[0], v1[1]); w.w = pk2(v1[2], v1[3]); *(u32x4*)(outb + o) = w;
                    ss += v0[0] * v0[0] + v0[1] * v0[1] + v0[2] * v0[2] + v0[3] * v0[3] + v1[0] * v1[0] + v1[1] * v1[1] + v1[2] * v1[2] + v1[3] * v1[3]; }
                ss += __shfl_xor(ss, 16); ss += __shfl_xor(ss, 32);
                if (fq == 0) atomicAdd(rss + row, ss); }
        }
    }
};
__device__ __forceinline__ f32x4 silu4(const f32x4 x) {
    const f32x4 t = x * (-1.4426950408889634f); f32x4 e; e[0] = __builtin_amdgcn_exp2f(t[0]); e[1] = __builtin_amdgcn_exp2f(t[1]); e[2] = __builtin_amdgcn_exp2f(t[2]); e[3] = __builtin_amdgcn_exp2f(t[3]);
    const f32x4 d = e + 1.0f; f32x4 rc; rc[0] = __builtin_amdgcn_rcpf(d[0]); rc[1] = __builtin_amdgcn_rcpf(d[1]); rc[2] = __builtin_amdgcn_rcpf(d[2]); rc[3] = __builtin_amdgcn_rcpf(d[3]);
    return x * rc;
}
__device__ __forceinline__ f32x4 ror1_4(const f32x4 v) { f32x4 r; r[0] = dpp_rot<0x121>(v[0]); r[1] = dpp_rot<0x121>(v[1]); r[2] = dpp_rot<0x121>(v[2]); r[3] = dpp_rot<0x121>(v[3]); return r; }
struct EpiUp {
    static constexpr bool PERM = false, PERM_A = true;
    bf16_t* act; float* edge; const float* rss; const float* cw;
    __device__ __forceinline__ void operator()(AccRef acc, const Unit& u, int wr, int wc, int fr, int fq) const {
        { const int l_ = lane_opaque(); fr = l_ & 15; fq = l_ >> 4; }
#pragma unroll
        for (int ai = 0; ai < 2; ++ai) {
            const int rowg = u.pm * 256 + ai * 128 + wr * 64;
            const int row0 = rowg + 4 * fr;
            float rs[4];
#pragma unroll
            for (int m = 0; m < 4; ++m) rs[m] = rsqrtf(rss[row0 + m] * (1.f / D_) + EPS_);
            float* eg = edge + (size_t)(rowg >> 6) * 4 * NUP;
#pragma unroll
            for (int n = 0; n < 2; ++n) {
                const int cin = wc * 32 + n * 16 + 4 * fq;
                const int colg = u.pn * 128 + cin;
                const int np = u.pn * 256 + cin;
                f32x4 sg[4];
                {
                    const f32x4 w0 = *(const f32x4*)(cw + colg), w1 = *(const f32x4*)(cw + NUP + colg), w2 = *(const f32x4*)(cw + 2 * NUP + colg);
                    const f32x4 g0 = acc[ai][0][0][n] * rs[0], g1 = acc[ai][0][1][n] * rs[1], g2 = acc[ai][0][2][n] * rs[2], g3 = acc[ai][0][3][n] * rs[3];
                    const f32x4 p3 = ror1_4(g3), p2 = ror1_4(g2);
                    sg[0] = silu4(w0 * p2 + w1 * p3 + w2 * g0);
                    sg[1] = silu4(w0 * p3 + w1 * g0 + w2 * g1);
                    sg[2] = silu4(w0 * g0 + w1 * g1 + w2 * g2);
                    sg[3] = silu4(w0 * g1 + w1 * g2 + w2 * g3);
                    if (fr == 0) { *(f32x4*)(eg + 2 * NUP + np) = g0; *(f32x4*)(eg + 3 * NUP + np) = g1; }
                    if (fr == 15) { *(f32x4*)(eg + np) = g2; *(f32x4*)(eg + NUP + np) = g3; }
                    __builtin_amdgcn_sched_barrier(0);
                }
                {
                    const f32x4 w0 = *(const f32x4*)(cw + DFF + colg), w1 = *(const f32x4*)(cw + NUP + DFF + colg), w2 = *(const f32x4*)(cw + 2 * NUP + DFF + colg);
                    const f32x4 v0 = acc[ai][1][0][n] * rs[0], v1 = acc[ai][1][1][n] * rs[1], v2 = acc[ai][1][2][n] * rs[2], v3 = acc[ai][1][3][n] * rs[3];
                    const f32x4 p3 = ror1_4(v3), p2 = ror1_4(v2);
                    f32x4 r[4];
                    r[0] = sg[0] * (w0 * p2 + w1 * p3 + w2 * v0);
                    r[1] = sg[1] * (w0 * p3 + w1 * v0 + w2 * v1);
                    r[2] = sg[2] * (w0 * v0 + w1 * v1 + w2 * v2);
                    r[3] = sg[3] * (w0 * v1 + w1 * v2 + w2 * v3);
#pragma unroll
                    for (int m = 0; m < 4; ++m)
                        if (!(m < 2 && fr == 0)) { u32x2 w; w.x = pk2(r[m][0], r[m][1]); w.y = pk2(r[m][2], r[m][3]); *(u32x2*)(act + (size_t)(row0 + m) * DFF + colg) = w; }
                    if (fr == 0) { *(f32x4*)(eg + 2 * NUP + np + 128) = v0; *(f32x4*)(eg + 3 * NUP + np + 128) = v1; }
                    if (fr == 15) { *(f32x4*)(eg + np + 128) = v2; *(f32x4*)(eg + NUP + np + 128) = v3; }
                    __builtin_amdgcn_sched_barrier(0);
                }
            }
        }
    }
};
struct EpiPle {
    static constexpr bool PERM = true, PERM_A = false;
    const bf16_t* x2b; bf16_t* x3b; const bf16_t* pp; const float* rss2; float* rss3;
    __device__ __forceinline__ void operator()(AccRef acc, const Unit& u, int wr, int wc, int fr, int fq) const {
        { const int l_ = lane_opaque(); fr = l_ & 15; fq = l_ >> 4; }
        const int row0 = u.pm * 256 + wr * 64 + fr, col0 = u.pn * 256 + wc * 32 + 8 * fq;
#pragma unroll
        for (int ai = 0; ai < 2; ++ai) {
            u32x4 xb[4][2], pb[4][2]; float rsv[4];
#pragma unroll
            for (int m = 0; m < 4; ++m) { rsv[m] = rss2[row0 + ai * 128 + m * 16];
#pragma unroll
                for (int bj = 0; bj < 2; ++bj) { const size_t o = (size_t)(row0 + ai * 128 + m * 16) * D_ + col0 + bj * 128; xb[m][bj] = *(const u32x4*)(x2b + o); pb[m][bj] = *(const u32x4*)(pp + o); } }
            __builtin_amdgcn_sched_barrier(0);
#pragma unroll
            for (int m = 0; m < 4; ++m) { const int row = row0 + ai * 128 + m * 16; const size_t ro = (size_t)row * D_ + col0; float ss = 0.f;
                const float rs = rsqrtf(rsv[m] * (1.f / D_) + EPS_);
#pragma unroll
                for (int bj = 0; bj < 2; ++bj) { const size_t o = ro + bj * 128; const f32x4 a0 = acc[ai][bj][m][0] * rs, a1 = acc[ai][bj][m][1] * rs;
                    const u32x4 xw = xb[m][bj], pw = pb[m][bj];
                    f32x4 v0, v1;
                    v0[0] = blo(xw.x) + sigmoid_f(a0[0]) * blo(pw.x); v0[1] = bhi(xw.x) + sigmoid_f(a0[1]) * bhi(pw.x); v0[2] = blo(xw.y) + sigmoid_f(a0[2]) * blo(pw.y); v0[3] = bhi(xw.y) + sigmoid_f(a0[3]) * bhi(pw.y);
                    v1[0] = blo(xw.z) + sigmoid_f(a1[0]) * blo(pw.z); v1[1] = bhi(xw.z) + sigmoid_f(a1[1]) * bhi(pw.z); v1[2] = blo(xw.w) + sigmoid_f(a1[2]) * blo(pw.w); v1[3] = bhi(xw.w) + sigmoid_f(a1[3]) * bhi(pw.w);
                    u32x4 w; w.x = pk2(v0[0], v0[1]); w.y = pk2(v0[2], v0[3]); w.z = pk2(v1[0], v1[1]); w.w = pk2(v1[2], v1[3]); *(u32x4*)(x3b + o) = w;
                    ss += v0[0] * v0[0] + v0[1] * v0[1] + v0[2] * v0[2] + v0[3] * v0[3] + v1[0] * v1[0] + v1[1] * v1[1] + v1[2] * v1[2] + v1[3] * v1[3]; }
                ss += __shfl_xor(ss, 16); ss += __shfl_xor(ss, 32);
                if (fq == 0) atomicAdd(rss3 + row, ss); }
        }
    }
};
template <class Epi> __device__ __forceinline__ void run_gemm_sub(LAS unsigned char* lds, const bf16_t* A, const bf16_t* Bt, int M, int N, int K, const Epi& E, const int wave_s, const int G, const int c) {
    pg8::Gemm g; g.A = A; g.Bt = Bt; g.M = M; g.N = N; g.K = K; pg8::StaticOrder S; S.init(M, N, G, c); pg8::gemm_phase(lds, g, S, E, wave_s);
}
template <class Epi> __device__ __forceinline__ void run_gemm(LAS unsigned char* lds, const bf16_t* A, const bf16_t* Bt, int M, int N, int K, const Epi& E, const int wave_s) {
    pg8::Gemm g; g.A = A; g.Bt = Bt; g.M = M; g.N = N; g.K = K; pg8::StaticOrder S; S.init(M, N, (int)gridDim.x, (int)blockIdx.x); pg8::gemm_phase(lds, g, S, E, wave_s);
}

struct TItem { const float* W; int K, N, k0, n0; bf16_t* WT; int drow0; const float* gk; };
__device__ __forceinline__ void transpose_load(const TItem& t, float (&tv)[32], int lane) {
#pragma unroll
    for (int i = 0; i < 32; ++i) tv[i] = t.W[(size_t)(t.k0 + 2 * i + (lane >> 5)) * t.N + t.n0 + (lane & 31)];
}
__device__ __forceinline__ void transpose_store(const TItem& t, const float (&tv)[32], LAS float* scr, int lane) {
#pragma unroll
    for (int i = 0; i < 32; ++i) { const int kk = 2 * i + (lane >> 5); float v = tv[i]; if (t.gk) v *= t.gk[t.k0 + kk]; scr[kk * 33 + (lane & 31)] = v; }
    LDS_WAIT();
    const int c = lane & 7;
#pragma unroll
    for (int j = 0; j < 4; ++j) { const int n = (lane >> 3) + 8 * j; const LAS float* s = scr + (8 * c) * 33 + n;
        u32x4 o; o.x = pk2(s[0 * 33], s[1 * 33]); o.y = pk2(s[2 * 33], s[3 * 33]); o.z = pk2(s[4 * 33], s[5 * 33]); o.w = pk2(s[6 * 33], s[7 * 33]);
        *(u32x4*)(t.WT + (size_t)(t.drow0 + n) * t.K + t.k0 + 8 * c) = o; }
    LDS_WAIT();
}
__device__ __forceinline__ TItem early_item(const Args& a, unsigned char* ws, int it) {
    constexpr int I_IN = 32 * 224, I_OUT = 32 * 64; TItem t; t.gk = nullptr;
    if (it < I_IN) { const int kb = it / 224, nb = it % 224; t.W = a.in[3]; t.K = D_; t.N = INCOLS; t.k0 = 64 * kb; t.n0 = 32 * nb; t.WT = (bf16_t*)(ws + WS_WIN); t.drow0 = 32 * nb; }
    else if (it < I_IN + I_OUT) { const int r = it - I_IN, kb = r / 64, nb = r % 64; t.W = a.in[9]; t.K = D_; t.N = D_; t.k0 = 64 * kb; t.n0 = 32 * nb; t.WT = (bf16_t*)(ws + WS_WOUT); t.drow0 = 32 * nb; }
    else { const int r = it - I_IN - I_OUT, kb = r / 64, nb = r % 64; t.W = a.in[16]; t.K = PLE_; t.N = D_; t.k0 = 64 * kb; t.n0 = 32 * nb; t.WT = (bf16_t*)(ws + WS_WPP); t.drow0 = 32 * nb; }
    return t;
}
__device__ __forceinline__ TItem late_item(const Args& a, unsigned char* ws, int it) {
    constexpr int I_UP = 32 * 352, I_DN = 88 * 64; TItem t;
    if (it < I_UP) { const int kb = it / 352, nb = it % 352, n0 = 32 * nb; t.W = a.in[11]; t.K = D_; t.N = NUP; t.k0 = 64 * kb; t.n0 = n0; t.WT = (bf16_t*)(ws + WS_WUP);
        t.drow0 = n0 < DFF ? (n0 / 128) * 256 + (n0 % 128) : ((n0 - DFF) / 128) * 256 + 128 + ((n0 - DFF) % 128); t.gk = a.in[10]; }
    else if (it < I_UP + I_DN) { const int r = it - I_UP, kb = r / 64, nb = r % 64; t.W = a.in[13]; t.K = DFF; t.N = D_; t.k0 = 64 * kb; t.n0 = 32 * nb; t.WT = (bf16_t*)(ws + WS_WDOWN); t.drow0 = 32 * nb; t.gk = nullptr; }
    else { const int r = it - I_UP - I_DN, kb = r / 64, nb = r % 64; t.W = a.in[15]; t.K = D_; t.N = D_; t.k0 = 64 * kb; t.n0 = 32 * nb; t.WT = (bf16_t*)(ws + WS_WPG); t.drow0 = 32 * nb; t.gk = a.in[14]; }
    return t;
}
template <bool LATE> __device__ __forceinline__ void transpose_items(const Args& a, unsigned char* ws, LAS float* scr, int lane, int first, int step, int total) {
    if (first >= total) return;
    TItem cur = LATE ? late_item(a, ws, first) : early_item(a, ws, first);
    float tv[32]; transpose_load(cur, tv, lane);
    for (int it = first; it < total; it += step) {
        const int nit = it + step; TItem nx = cur; float tn[32];
        if (nit < total) { nx = LATE ? late_item(a, ws, nit) : early_item(a, ws, nit); transpose_load(nx, tn, lane); }
        else {
#pragma unroll
            for (int i = 0; i < 32; ++i) tn[i] = 0.f; }
        transpose_store(cur, tv, scr, lane);
        cur = nx;
#pragma unroll
        for (int i = 0; i < 32; ++i) tv[i] = tn[i];
    }
}

__device__ __forceinline__ void phase0(const Args& a, LAS unsigned char* lds, const int wave_s) {
    TID_SETUP;
    const int gw = blockIdx.x * 8 + wave, NGW = gridDim.x * 8, gt = blockIdx.x * 512 + tid, NGT = gridDim.x * 512;
    unsigned char* ws = a.ws;
    float* rss = (float*)(ws + WS_RSS);
    for (int i = gt; i < 3 * T_; i += NGT) rss[i] = 0.f;
    { float* ab0 = (float*)(ws + WS_AB); for (int i = gt; i < T_ * 16; i += NGT) ab0[i] = 0.f; }
    { bf16_t* wab = (bf16_t*)(ws + WS_WAB); const float* w_in = a.in[3];
      for (int i = gt; i < 16 * D_; i += NGT) { const int n = i >> 11, k = i & 2047; wab[i] = f2b(w_in[(size_t)k * INCOLS + NPROJ + n]); } }
    { const f32x4* p4 = (const f32x4*)a.in[1]; u32x2* pb = (u32x2*)(ws + WS_PB);
      for (int i = gt; i < T_ * PLE_ / 4; i += NGT) { const f32x4 v = p4[i]; u32x2 o; o.x = pk2(v[0], v[1]); o.y = pk2(v[2], v[3]); pb[i] = o; } }
    { const float* x = a.in[0]; const f32x4* g4 = (const f32x4*)a.in[2]; bf16_t* hb = (bf16_t*)(ws + WS_B);
      for (int row = gw; row < T_; row += NGW) {
          const f32x4* xr = (const f32x4*)(x + (size_t)row * D_) + lane; f32x4 v[8]; float s = 0.f;
#pragma unroll
          for (int j = 0; j < 8; ++j) { v[j] = xr[64 * j]; s += v[j][0] * v[j][0] + v[j][1] * v[j][1] + v[j][2] * v[j][2] + v[j][3] * v[j][3]; }
          const float rstd = rsqrtf(wave_sum(s) * (1.f / D_) + EPS_);
          u32x2* o8 = (u32x2*)(hb + (size_t)row * D_) + lane;
#pragma unroll
          for (int j = 0; j < 8; ++j) { const f32x4 g = g4[lane + 64 * j]; u32x2 o; o.x = pk2(v[j][0] * rstd * g[0], v[j][1] * rstd * g[1]); o.y = pk2(v[j][2] * rstd * g[2], v[j][3] * rstd * g[3]); o8[64 * j] = o; }
      } }
    { LAS float* scr = (LAS float*)(lds + wave * 8448);
      transpose_items<false>(a, ws, scr, lane, gw, NGW, 32 * 224 + 32 * 64 + 4 * 64); }
}
__device__ __forceinline__ void late_weights(const Args& a, LAS unsigned char* lds, const int wave_s, const int blk, const int nblk) {
    TID_SETUP; (void)tid; const int gw = blk * 8 + wave, NGW = nblk * 8;
    unsigned char* ws = a.ws; LAS float* scr = (LAS float*)(lds + wave * 8448);
    transpose_items<true>(a, ws, scr, lane, gw, NGW, 32 * 352 + 88 * 64 + 32 * 64);
    __syncthreads();
}

__device__ __forceinline__ void phase1(const Args& a, LAS unsigned char* lds, const int wave_s) {
    TID_SETUP; (void)tid; const int gw = blockIdx.x * 8 + wave, NGW = gridDim.x * 8;
    unsigned char* ws = a.ws; const bf16_t* hb = (const bf16_t*)(ws + WS_B);
    { const bf16_t* wab = (const bf16_t*)(ws + WS_WAB); float* AB = (float*)(ws + WS_AB); const int l15 = lane & 15, q = lane >> 4;
      for (int it2 = gw; it2 < 2 * (T_ / 16); it2 += NGW) {
          const int tt = it2 >> 1, kh = it2 & 1;
          f32x4 acc = (f32x4){0.f, 0.f, 0.f, 0.f};
          const bf16_t* ap = hb + (size_t)(16 * tt + l15) * D_ + 1024 * kh + 8 * q; const bf16_t* bp = wab + (size_t)l15 * D_ + 1024 * kh + 8 * q;
#pragma unroll 16
          for (int ks = 0; ks < 32; ++ks) { const bf16x8 av = *(const bf16x8*)(ap + 32 * ks), bv = *(const bf16x8*)(bp + 32 * ks); acc = __builtin_amdgcn_mfma_f32_16x16x32_bf16(av, bv, acc, 0, 0, 0); }
#pragma unroll
          for (int j = 0; j < 4; ++j) atomicAdd(AB + (size_t)(16 * tt + 4 * q + j) * 16 + l15, acc[j]);
      } }
    EpiBf16Store E; E.O = (bf16_t*)(ws + WS_PROJ); E.ldc = NPROJ;
    run_gemm(lds, hb, (const bf16_t*)(ws + WS_WIN), T_, NPROJ, D_, E, wave_s);
}

template <int I, int JJ> __device__ __forceinline__ void sub_group(float (&Tc)[64], float (&rb)[64], float& s0, float& s1, float& s2, float& s3, const LAS float* LM) {
    if constexpr (4 * JJ < I + 1) {
        if constexpr (4 * JJ + 0 < I) s0 += rb[4 * JJ + 0] * Tc[4 * JJ + 0];
        if constexpr (4 * JJ + 1 < I) s1 += rb[4 * JJ + 1] * Tc[4 * JJ + 1];
        if constexpr (4 * JJ + 2 < I) s2 += rb[4 * JJ + 2] * Tc[4 * JJ + 2];
        if constexpr (4 * JJ + 3 < I) s3 += rb[4 * JJ + 3] * Tc[4 * JJ + 3];
        if constexpr (I + 1 < 64) { const f32x4 v = *(const LAS f32x4*)(LM + (I + 1) * 64 + 4 * JJ); rb[4 * JJ + 0] = v[0]; rb[4 * JJ + 1] = v[1]; rb[4 * JJ + 2] = v[2]; rb[4 * JJ + 3] = v[3]; }
        __builtin_amdgcn_sched_barrier(0);
        if constexpr (JJ + 1 < 16) sub_group<I, JJ + 1>(Tc, rb, s0, s1, s2, s3, LM);
    }
}
template <int I> __device__ __forceinline__ void sub_row(float (&Tc)[64], float (&rb)[64], const float fl, const LAS float* LM) {
    float s0 = 0.f, s1 = 0.f, s2 = 0.f, s3 = 0.f;
    sub_group<I, 0>(Tc, rb, s0, s1, s2, s3, LM);
    Tc[I] = fmaxf(0.f, 1.f - fabsf(fl - (float)I)) - ((s0 + s1) + (s2 + s3));
    if constexpr (I + 1 < 64) sub_row<I + 1>(Tc, rb, fl, LM);
}
__device__ __forceinline__ void phase_chunk(const Args& a, LAS unsigned char* lds, const int wave_s) {
    TID_SETUP; const int l15 = lane & 15, q = lane >> 4;
    unsigned char* ws = a.ws;
    const bf16_t* proj = (const bf16_t*)(ws + WS_PROJ); const float* AB = (const float*)(ws + WS_AB);
    const float* cwq = a.in[5]; const float* a_log = a.in[6]; const float* dt_bias = a.in[7];
    bf16_t* Ug = (bf16_t*)(ws + WS_U); bf16_t* Wg = (bf16_t*)(ws + WS_W); bf16_t* QDg = (bf16_t*)(ws + WS_QD); bf16_t* KDTg = (bf16_t*)(ws + WS_KDT); bf16_t* QKg = (bf16_t*)(ws + WS_QK);
    float* GL = (float*)(ws + WS_GL);
    float* LMg = (float*)(ws + WS_O);
    bf16_t* RBT = (bf16_t*)(ws + WS_B);
    for (int base = blockIdx.x; base < NCHUNK; base += 8 * gridDim.x) {
        float av_n = 0.f, bv_n = 0.f, al_n = 0.f, dtb_n = 0.f; unsigned xr_n[3][11]; float2 cw_n[3][4];
#define P2_LOAD(chx) do { const int n_ = (chx) & 63, bh_ = (chx) >> 6, h_ = bh_ & 7, b_ = bh_ >> 3; const int s0_ = n_ * 64; const size_t t0_ = (size_t)b_ * SEQ_ + s0_; \
            av_n = AB[(t0_ + lane) * 16 + h_]; bv_n = AB[(t0_ + lane) * 16 + 8 + h_]; al_n = a_log[h_]; dtb_n = dt_bias[h_]; \
            _Pragma("unroll") for (int mat = 0; mat < 3; ++mat) _Pragma("unroll") for (int rr = 0; rr < 11; ++rr) \
                xr_n[mat][rr] = (s0_ + 8 * wave - 3 + rr >= 0) ? *(const unsigned*)(proj + (t0_ + (size_t)(8 * wave + rr) - 3) * NPROJ + 3072 + mat * 1024 + h_ * 128 + 2 * lane) : 0u; \
            _Pragma("unroll") for (int mat = 0; mat < 3; ++mat) _Pragma("unroll") for (int j = 0; j < 4; ++j) cw_n[mat][j] = *(const float2*)(cwq + j * 3072 + mat * 1024 + h_ * 128 + 2 * lane); } while (0)
        P2_LOAD(base);
        for (int kk8 = 0; kk8 < 8; ++kk8) {
            const int ch = base + kk8 * gridDim.x; if (ch >= NCHUNK) break;
            int zv; asm volatile("v_mov_b32 %0, 0" : "=v"(zv));
            LAS unsigned char* ldz = lds + zv;
            LAS bf16_t* QS = (LAS bf16_t*)(ldz); LAS bf16_t* KS = (LAS bf16_t*)(ldz + 17408);
            LAS float* GCs = (LAS float*)(ldz + 34816); LAS float* BETAs = GCs + 64; LAS float* EGs = GCs + 128;
            const int n = ch & 63, bh = ch >> 6, h = bh & 7, b = bh >> 3;
            const int s0 = n * 64; const size_t t0 = (size_t)b * SEQ_ + s0;
            {
                const float av = av_n, bv = bv_n, al = al_n, dtb = dtb_n;
                unsigned xr[3][11]; float2 cwv[3][4];
#pragma unroll
                for (int mat = 0; mat < 3; ++mat) {
#pragma unroll
                    for (int rr = 0; rr < 11; ++rr) xr[mat][rr] = xr_n[mat][rr];
#pragma unroll
                    for (int j = 0; j < 4; ++j) cwv[mat][j] = cw_n[mat][j];
                }
                { const int chn = ch + (int)gridDim.x; if (kk8 + 1 < 8 && chn < NCHUNK) P2_LOAD(chn); }
                const float xg = av + dtb; const float sp = fmaxf(xg, 0.f) + log1pf(__expf(-fabsf(xg)));
                float g = -__expf(al) * sp;
#pragma unroll
                for (int o = 1; o < 64; o <<= 1) { const float tt = __shfl_up(g, o); if (lane >= o) g += tt; }
                const float betal = 1.f / (1.f + __expf(-bv)), egl = __expf(g);
                if (wave == 0) { GCs[lane] = g; BETAs[lane] = betal; EGs[lane] = egl; if (lane == 63) GL[ch] = egl; }
                const float gc63 = __shfl(g, 63);
                float qv[8][2], kv[8][2], vv[8][2];
#pragma unroll
                for (int i = 0; i < 8; ++i) {
                    float a0 = 0.f, a1 = 0.f, b0 = 0.f, b1 = 0.f, c0 = 0.f, c1 = 0.f;
#pragma unroll
                    for (int j = 0; j < 4; ++j) {
                        a0 += cwv[0][j].x * blo(xr[0][i + j]); a1 += cwv[0][j].y * bhi(xr[0][i + j]);
                        b0 += cwv[1][j].x * blo(xr[1][i + j]); b1 += cwv[1][j].y * bhi(xr[1][i + j]);
                        c0 += cwv[2][j].x * blo(xr[2][i + j]); c1 += cwv[2][j].y * bhi(xr[2][i + j]);
                    }
                    a0 = silu_f(a0); a1 = silu_f(a1); b0 = silu_f(b0); b1 = silu_f(b1); c0 = silu_f(c0); c1 = silu_f(c1);
                    const float rq = rsqrtf(wave_sum(a0 * a0 + a1 * a1) + EPS_) * 0.08838834764831845f, rk = rsqrtf(wave_sum(b0 * b0 + b1 * b1) + EPS_);
                    qv[i][0] = a0 * rq; qv[i][1] = a1 * rq; kv[i][0] = b0 * rk; kv[i][1] = b1 * rk; vv[i][0] = c0; vv[i][1] = c1;
                }
                float bet[8], egr[8], kdf[8];
#pragma unroll
                for (int i = 0; i < 8; ++i) { const int r = 8 * wave + i; bet[i] = __shfl(betal, r); egr[i] = __shfl(egl, r); kdf[i] = __expf(gc63 - __shfl(g, r)); }
#pragma unroll
                for (int i = 0; i < 8; ++i) {
                    const int r = 8 * wave + i;
                    *(LAS unsigned*)(QS + r * 136 + 2 * lane) = pk2(qv[i][0], qv[i][1]);
                    *(LAS unsigned*)(KS + r * 136 + 2 * lane) = pk2(kv[i][0], kv[i][1]);
                    *(unsigned*)(QDg + (size_t)ch * 8192 + r * 128 + 2 * lane) = pk2(qv[i][0] * egr[i], qv[i][1] * egr[i]);
                }
#pragma unroll
                for (int cc = 0; cc < 2; ++cc) {
                    u32x4 o;
                    o.x = pk2(vv[0][cc] * bet[0], vv[1][cc] * bet[1]); o.y = pk2(vv[2][cc] * bet[2], vv[3][cc] * bet[3]); o.z = pk2(vv[4][cc] * bet[4], vv[5][cc] * bet[5]); o.w = pk2(vv[6][cc] * bet[6], vv[7][cc] * bet[7]);
                    *(u32x4*)(RBT + (size_t)ch * 16384 + (size_t)(2 * lane + cc) * 64 + 8 * wave) = o;
                    o.x = pk2(kv[0][cc] * bet[0] * egr[0], kv[1][cc] * bet[1] * egr[1]); o.y = pk2(kv[2][cc] * bet[2] * egr[2], kv[3][cc] * bet[3] * egr[3]);
                    o.z = pk2(kv[4][cc] * bet[4] * egr[4], kv[5][cc] * bet[5] * egr[5]); o.w = pk2(kv[6][cc] * bet[6] * egr[6], kv[7][cc] * bet[7] * egr[7]);
                    *(u32x4*)(RBT + (size_t)ch * 16384 + (size_t)(128 + 2 * lane + cc) * 64 + 8 * wave) = o;
                    o.x = pk2(kv[0][cc] * kdf[0], kv[1][cc] * kdf[1]); o.y = pk2(kv[2][cc] * kdf[2], kv[3][cc] * kdf[3]); o.z = pk2(kv[4][cc] * kdf[4], kv[5][cc] * kdf[5]); o.w = pk2(kv[6][cc] * kdf[6], kv[7][cc] * kdf[7]);
                    *(u32x4*)(KDTg + (size_t)ch * 8192 + (size_t)(2 * lane + cc) * 64 + 8 * wave) = o;
                }
            }
            __syncthreads();
            {
                const int ti = wave >> 1;
#pragma unroll
                for (int tjj = 0; tjj < 2; ++tjj) {
                    const int tj = 2 * (wave & 1) + tjj;
                    bf16_t* qkp = QKg + (size_t)ch * 4096;
                    if (tj > ti) {
#pragma unroll
                        for (int j = 0; j < 4; ++j) qkp[(16 * ti + 4 * q + j) * 64 + 16 * tj + l15] = 0;
                        continue;
                    }
                    f32x4 akk = (f32x4){0.f, 0.f, 0.f, 0.f}, aqk = akk;
#pragma unroll
                    for (int ks = 0; ks < 4; ++ks) {
                        const bf16x8 bk = *(const LAS bf16x8*)(KS + (16 * tj + l15) * 136 + 32 * ks + 8 * q);
                        const bf16x8 ak = *(const LAS bf16x8*)(KS + (16 * ti + l15) * 136 + 32 * ks + 8 * q);
                        const bf16x8 aq = *(const LAS bf16x8*)(QS + (16 * ti + l15) * 136 + 32 * ks + 8 * q);
                        akk = __builtin_amdgcn_mfma_f32_16x16x32_bf16(ak, bk, akk, 0, 0, 0);
                        aqk = __builtin_amdgcn_mfma_f32_16x16x32_bf16(aq, bk, aqk, 0, 0, 0);
                    }
                    const int c = 16 * tj + l15; const float gcc = GCs[c];
#pragma unroll
                    for (int j = 0; j < 4; ++j) {
                        const int i = 16 * ti + 4 * q + j;
                        const float dec = (i >= c) ? __expf(GCs[i] - gcc) : 0.f;
                        if (i > c) LMg[(size_t)ch * 4096 + i * 64 + c] = akk[j] * dec * BETAs[i];
                        qkp[i * 64 + c] = f2b((i >= c) ? aqk[j] * dec : 0.f);
                    }
                }
            }
            __syncthreads();
        }
        __syncthreads();
#undef P2_LOAD
        {
            const int ch = base + wave * gridDim.x;
            if (ch < NCHUNK) {
                int zv; asm volatile("v_mov_b32 %0, 0" : "=v"(zv));
                LAS unsigned char* slot = lds + zv + wave * 16384;
                const u32x4* src = (const u32x4*)(LMg + (size_t)ch * 4096) + lane;
                u32x4 cp[16];
#pragma unroll
                for (int it = 0; it < 16; ++it) cp[it] = src[64 * it];
#pragma unroll
                for (int it = 0; it < 16; ++it) *(LAS u32x4*)(slot + (it * 64 + lane) * 16) = cp[it];
                LDS_WAIT();
                const LAS float* LM = (const LAS float*)slot;
                float Tc[64];
                float fl; asm volatile("v_cvt_f32_i32 %0, %1" : "=v"(fl) : "v"(lane));
                float rb[64];
                Tc[0] = fmaxf(0.f, 1.f - fabsf(fl));
                { const f32x4 v = *(const LAS f32x4*)(LM + 64); rb[0] = v[0]; rb[1] = v[1]; rb[2] = v[2]; rb[3] = v[3]; }
                sub_row<1>(Tc, rb, fl, LM);
                LDS_WAIT();
                LAS bf16_t* TM = (LAS bf16_t*)slot;
#pragma unroll
                for (int i = 0; i < 64; ++i) TM[i * 72 + lane] = f2b(Tc[i]);
            }
        }
        __syncthreads();
        for (int kk8 = 0; kk8 < 8; ++kk8) {
            const int ch = base + kk8 * gridDim.x; if (ch >= NCHUNK) break;
            const int ln3 = lane_opaque(), l15 = ln3 & 15, q = ln3 >> 4;
            int zv; asm volatile("v_mov_b32 %0, 0" : "=v"(zv));
            const LAS bf16_t* TM = (const LAS bf16_t*)(lds + zv + kk8 * 16384);
#pragma unroll
            for (int nn = 0; nn < 2; ++nn) {
                const int nt = 2 * wave + nn;
                const bf16_t* XB = RBT + (size_t)ch * 16384 + (size_t)(16 * nt + l15) * 64 + 8 * q;
                const bf16x8 bv0 = *(const bf16x8*)(XB), bv1 = *(const bf16x8*)(XB + 32);
                bf16_t* dst = ((nt < 8) ? Ug : Wg) + (size_t)ch * 8192 + 16 * (nt & 7) + l15;
                const float sgn = (nt < 8) ? 1.f : -1.f;
#pragma unroll
                for (int ti = 0; ti < 4; ++ti) {
                    f32x4 acc = (f32x4){0.f, 0.f, 0.f, 0.f};
                    const bf16x8 av0 = *(const LAS bf16x8*)(TM + (16 * ti + l15) * 72 + 8 * q), av1 = *(const LAS bf16x8*)(TM + (16 * ti + l15) * 72 + 32 + 8 * q);
                    acc = __builtin_amdgcn_mfma_f32_16x16x32_bf16(av0, bv0, acc, 0, 0, 0);
                    acc = __builtin_amdgcn_mfma_f32_16x16x32_bf16(av1, bv1, acc, 0, 0, 0);
#pragma unroll
                    for (int j = 0; j < 4; ++j) dst[(16 * ti + 4 * q + j) * 128] = f2b(acc[j] * sgn);
                }
            }
        }
        __syncthreads();
    }
}

__device__ __forceinline__ bf16x8 ld_a8(const LAS unsigned char* p) {
    const u32x2 lo = *(const LAS u32x2*)p, hi = *(const LAS u32x2*)(p + 32);
    u32x4 v; v.x = lo.x; v.y = lo.y; v.z = hi.x; v.w = hi.y; return __builtin_bit_cast(bf16x8, v);
}
__device__ __forceinline__ bf16x8 pack_frag(const f32x4 a, const f32x4 b) {
    u32x4 v; v.x = pk2(a[0], a[1]); v.y = pk2(a[2], a[3]); v.z = pk2(b[0], b[1]); v.w = pk2(b[2], b[3]); return __builtin_bit_cast(bf16x8, v);
}
__device__ __forceinline__ void phase_scan(const Args& a, LAS unsigned char* lds, const int wave_s) {
    TID_SETUP; const int l15 = lane & 15, q = lane >> 4;
    unsigned char* ws = a.ws;
    const bf16_t* Ug = (const bf16_t*)(ws + WS_U); const bf16_t* Wg = (const bf16_t*)(ws + WS_W); const bf16_t* QDg = (const bf16_t*)(ws + WS_QD);
    const bf16_t* KDTg = (const bf16_t*)(ws + WS_KDT); const bf16_t* QKg = (const bf16_t*)(ws + WS_QK); const float* GL = (const float*)(ws + WS_GL);
    bf16_t* Og = (bf16_t*)(ws + WS_O);
    constexpr int BUF = 66560, WSo = 0, QDo = 17408, KDTo = 34816, QKo = 53248, USo = 62464;
    {
        const int sub_g = gridDim.x > 128 ? (int)gridDim.x - 128 : (int)gridDim.x, sub_c = gridDim.x > 128 ? (int)blockIdx.x - 128 : (int)blockIdx.x;
        if (sub_c >= 0) {
            late_weights(a, lds, wave_s, sub_c, sub_g);
            EpiBf16Store Epp; Epp.O = (bf16_t*)a.out; Epp.ldc = D_;
            run_gemm_sub(lds, (const bf16_t*)(ws + WS_PB), (const bf16_t*)(ws + WS_WPP), T_, D_, PLE_, Epp, wave_s, sub_g, sub_c);
            __syncthreads();
        }
    }
    for (int item = blockIdx.x; item < 128; item += gridDim.x) {
        const int bh = item >> 2, sl = item & 3, h = bh & 7, b = bh >> 3;
        LAS unsigned char* XS = lds + 2 * BUF;
        if (wave < 2) {
            const float glv = GL[bh * 64 + lane];
            const int e0 = 16 * wave;
            __builtin_amdgcn_s_setprio(3);
            LAS unsigned char* xsb = XS + wave * 6144; LAS unsigned char* xvb = xsb + 4096;
            f32x4 S[8];
#pragma unroll
            for (int mt = 0; mt < 8; ++mt) S[mt] = (f32x4){0.f, 0.f, 0.f, 0.f};
#pragma unroll
            for (int ks = 0; ks < 4; ++ks) *(LAS u32x4*)(xsb + (ks * 64 + lane) * 16) = (u32x4){0u, 0u, 0u, 0u};
            for (int n = 0; n < 64; ++n) {
                __syncthreads();
                const LAS unsigned char* buf = lds + (n & 1) * BUF;
                const float gl = __shfl(glv, n);
                f32x4 av[4];
                bf16x8 fa[16], fk[16], sb[4], vb[2];
                const LAS bf16_t* Us = (const LAS bf16_t*)(buf + USo);
#pragma unroll
                for (int ks = 0; ks < 4; ++ks)
#pragma unroll
                    for (int it = 0; it < 4; ++it) fa[ks * 4 + it] = ld_a8(buf + WSo + (16 * it + l15) * 272 + (32 * ks + 4 * q) * 2);
#pragma unroll
                for (int it = 0; it < 4; ++it)
#pragma unroll
                    for (int j = 0; j < 4; ++j) av[it][j] = b2f(Us[(16 * it + 4 * q + j) * 32 + e0 + l15]);
#pragma unroll
                for (int mt = 0; mt < 8; ++mt)
#pragma unroll
                    for (int ks = 0; ks < 2; ++ks) fk[mt * 2 + ks] = ld_a8(buf + KDTo + (16 * mt + l15) * 144 + (32 * ks + 4 * q) * 2);
#pragma unroll
                for (int ks = 0; ks < 4; ++ks) sb[ks] = pack_frag(S[2 * ks], S[2 * ks + 1]);
                __builtin_amdgcn_sched_barrier(0);
#pragma unroll
                for (int ks = 0; ks < 4; ++ks)
#pragma unroll
                    for (int it = 0; it < 4; ++it) av[it] = __builtin_amdgcn_mfma_f32_16x16x32_bf16(fa[ks * 4 + it], sb[ks], av[it], 0, 0, 0);
                __builtin_amdgcn_sched_barrier(0);
                vb[0] = pack_frag(av[0], av[1]); vb[1] = pack_frag(av[2], av[3]);
                *(LAS bf16x8*)(xvb + lane * 16) = vb[0]; *(LAS bf16x8*)(xvb + (64 + lane) * 16) = vb[1];
                __syncthreads();
#pragma unroll
                for (int mt = 0; mt < 8; ++mt) {
                    S[mt] = S[mt] * gl;
#pragma unroll
                    for (int ks = 0; ks < 2; ++ks) S[mt] = __builtin_amdgcn_mfma_f32_16x16x32_bf16(fk[mt * 2 + ks], vb[ks], S[mt], 0, 0, 0);
                }
                __builtin_amdgcn_sched_barrier(0);
#pragma unroll
                for (int ks = 0; ks < 4; ++ks) *(LAS bf16x8*)(xsb + (ks * 64 + lane) * 16) = pack_frag(S[2 * ks], S[2 * ks + 1]);
            }
        } else if (wave < 4) {
            const int w2 = wave - 2, e0 = 16 * w2;
            __builtin_amdgcn_s_setprio(2);
            const LAS unsigned char* xsb = XS + w2 * 6144; const LAS unsigned char* xvb = xsb + 4096;
            for (int n = 0; n < 64; ++n) {
                __syncthreads();
                const LAS unsigned char* buf = lds + (n & 1) * BUF;
                f32x4 ao[4];
                bf16x8 fq[16], fc[8], sb[4], vb[2];
#pragma unroll
                for (int ks = 0; ks < 4; ++ks) sb[ks] = *(const LAS bf16x8*)(xsb + (ks * 64 + lane) * 16);
#pragma unroll
                for (int ks = 0; ks < 4; ++ks)
#pragma unroll
                    for (int it = 0; it < 4; ++it) fq[ks * 4 + it] = ld_a8(buf + QDo + (16 * it + l15) * 272 + (32 * ks + 4 * q) * 2);
#pragma unroll
                for (int ks = 0; ks < 2; ++ks)
#pragma unroll
                    for (int it = 0; it < 4; ++it) fc[ks * 4 + it] = ld_a8(buf + QKo + (16 * it + l15) * 144 + (32 * ks + 4 * q) * 2);
#pragma unroll
                for (int it = 0; it < 4; ++it) ao[it] = (f32x4){0.f, 0.f, 0.f, 0.f};
                __builtin_amdgcn_sched_barrier(0);
#pragma unroll
                for (int ks = 0; ks < 4; ++ks)
#pragma unroll
                    for (int it = 0; it < 4; ++it) ao[it] = __builtin_amdgcn_mfma_f32_16x16x32_bf16(fq[ks * 4 + it], sb[ks], ao[it], 0, 0, 0);
                __syncthreads();
                vb[0] = *(const LAS bf16x8*)(xvb + lane * 16); vb[1] = *(const LAS bf16x8*)(xvb + (64 + lane) * 16);
#pragma unroll
                for (int ks = 0; ks < 2; ++ks)
#pragma unroll
                    for (int it = 0; it < 4; ++it) ao[it] = __builtin_amdgcn_mfma_f32_16x16x32_bf16(fc[ks * 4 + it], vb[ks], ao[it], 0, 0, 0);
                bf16_t* op = Og + ((size_t)b * SEQ_ + n * 64) * 1024 + h * 128 + 32 * sl + e0 + l15;
#pragma unroll
                for (int it = 0; it < 4; ++it)
#pragma unroll
                    for (int j = 0; j < 4; ++j) op[(size_t)(16 * it + 4 * q + j) * 1024] = f2b(ao[it][j]);
            }
        } else {
            const int lt = tid - 256;
            u32x4 r0[15], r1[15];
#define SC_GLOAD(R, nn) do { const size_t chh = (size_t)bh * 64 + (nn); \
                const u32x4* pw = (const u32x4*)(Wg + chh * 8192) + lt; const u32x4* pq = (const u32x4*)(QDg + chh * 8192) + lt; const u32x4* pk = (const u32x4*)(KDTg + chh * 8192) + lt; \
                const u32x4* pqk = (const u32x4*)(QKg + chh * 4096) + lt; \
                _Pragma("unroll") for (int _i = 0; _i < 4; ++_i) { R[_i] = pw[256 * _i]; R[4 + _i] = pq[256 * _i]; R[8 + _i] = pk[256 * _i]; } \
                R[12] = pqk[0]; R[13] = pqk[256]; R[14] = *(const u32x4*)(Ug + chh * 8192 + (lt >> 2) * 128 + 32 * sl + 8 * (lt & 3)); } while (0)
#define SC_LSTORE(R, bufp) do { int ltv = lt; asm volatile("" : "+v"(ltv)); \
                LAS unsigned char* _w = (bufp) + WSo + (ltv >> 4) * 272 + (ltv & 15) * 16; LAS unsigned char* _k = (bufp) + KDTo + (ltv >> 3) * 144 + (ltv & 7) * 16; \
                _Pragma("unroll") for (int _i = 0; _i < 4; ++_i) { *(LAS u32x4*)(_w + 4352 * _i) = R[_i]; *(LAS u32x4*)(_w + (QDo - WSo) + 4352 * _i) = R[4 + _i]; *(LAS u32x4*)(_k + 4608 * _i) = R[8 + _i]; } \
                *(LAS u32x4*)(_k + (QKo - KDTo)) = R[12]; *(LAS u32x4*)(_k + (QKo - KDTo) + 4608) = R[13]; *(LAS u32x4*)((bufp) + USo + ltv * 16) = R[14]; } while (0)
            SC_GLOAD(r0, 0);
            SC_LSTORE(r0, lds);
            SC_GLOAD(r0, 1);
            SC_GLOAD(r1, 2);
            for (int n = 0; n < 64; n += 2) {
                __syncthreads();
                SC_LSTORE(r0, lds + BUF);
                SC_GLOAD(r0, (n + 3 < 64 ? n + 3 : 63));
                __syncthreads();
                __syncthreads();
                if (n + 2 < 64) SC_LSTORE(r1, lds);
                SC_GLOAD(r1, (n + 4 < 64 ? n + 4 : 63));
                __syncthreads();
            }
#undef SC_GLOAD
#undef SC_LSTORE
        }
        __builtin_amdgcn_s_setprio(0);
        __syncthreads();
    }
}

__device__ __forceinline__ void phase_mix_out(const Args& a, const int wave_s) {
    TID_SETUP; const int gw = blockIdx.x * 8 + wave, NGW = gridDim.x * 8, gt = blockIdx.x * 512 + tid, NGT = gridDim.x * 512;
    unsigned char* ws = a.ws;
    const bf16_t* proj = (const bf16_t*)(ws + WS_PROJ); const bf16_t* Og = (const bf16_t*)(ws + WS_O); bf16_t* ycat = (bf16_t*)(ws + WS_YCAT);
    const float* dng = a.in[8]; const float* caw = a.in[4];
    {
        const int sub = lane >> 4, c8 = (lane & 15) * 8;
        const f32x4 g0 = *(const f32x4*)(dng + c8), g1 = *(const f32x4*)(dng + c8 + 4);
        constexpr int NIT = T_ * 8 / 4;
        for (int it0 = gw; it0 < NIT; it0 += 4 * NGW) {
            u32x4 ov[4], zv[4];
#pragma unroll
            for (int k = 0; k < 4; ++k) { const int it = it0 + k * NGW; if (it < NIT) { const int pair = it * 4 + sub, t = pair >> 3, h = pair & 7;
                ov[k] = *(const u32x4*)(Og + (size_t)t * 1024 + h * 128 + c8); zv[k] = *(const u32x4*)(proj + (size_t)t * NPROJ + 6144 + h * 128 + c8); } }
#pragma unroll
            for (int k = 0; k < 4; ++k) { const int it = it0 + k * NGW; if (it < NIT) { const int pair = it * 4 + sub, t = pair >> 3, h = pair & 7;
                float o[8] = {blo(ov[k].x), bhi(ov[k].x), blo(ov[k].y), bhi(ov[k].y), blo(ov[k].z), bhi(ov[k].z), blo(ov[k].w), bhi(ov[k].w)};
                const float z[8] = {blo(zv[k].x), bhi(zv[k].x), blo(zv[k].y), bhi(zv[k].y), blo(zv[k].z), bhi(zv[k].z), blo(zv[k].w), bhi(zv[k].w)};
                float ss = 0.f;
#pragma unroll
                for (int e = 0; e < 8; ++e) ss += o[e] * o[e];
                ss += __shfl_xor(ss, 1); ss += __shfl_xor(ss, 2); ss += __shfl_xor(ss, 4); ss += __shfl_xor(ss, 8);
                const float rs = rsqrtf(ss * (1.f / HD) + EPS_);
#pragma unroll
                for (int e = 0; e < 8; ++e) o[e] = o[e] * rs * (e < 4 ? g0[e & 3] : g1[e & 3]) * silu_f(z[e]);
                u32x4 w; w.x = pk2(o[0], o[1]); w.y = pk2(o[2], o[3]); w.z = pk2(o[4], o[5]); w.w = pk2(o[6], o[7]);
                *(u32x4*)(ycat + (size_t)t * D_ + 1024 + h * 128 + c8) = w; } }
        }
    }
    {
        for (int i = gt; i < T_ * 128; i += NGT) {
            const int t = i >> 7, c8 = (i & 127) * 8, s = t & (SEQ_ - 1);
            float accv[8] = {0.f, 0.f, 0.f, 0.f, 0.f, 0.f, 0.f, 0.f};
#pragma unroll
            for (int j = 0; j < 3; ++j) {
                if (s - 2 + j >= 0) {
                    const bf16_t* rp = proj + (size_t)(t - 2 + j) * NPROJ + c8;
                    const u32x4 xv = *(const u32x4*)(rp), cv = *(const u32x4*)(rp + 2048);
                    const f32x4 w0 = *(const f32x4*)(caw + j * 1024 + c8), w1 = *(const f32x4*)(caw + j * 1024 + c8 + 4);
                    accv[0] += w0[0] * blo(xv.x) * blo(cv.x); accv[1] += w0[1] * bhi(xv.x) * bhi(cv.x); accv[2] += w0[2] * blo(xv.y) * blo(cv.y); accv[3] += w0[3] * bhi(xv.y) * bhi(cv.y);
                    accv[4] += w1[0] * blo(xv.z) * blo(cv.z); accv[5] += w1[1] * bhi(xv.z) * bhi(cv.z); accv[6] += w1[2] * blo(xv.w) * blo(cv.w); accv[7] += w1[3] * bhi(xv.w) * bhi(cv.w);
                }
            }
            const u32x4 bv = *(const u32x4*)(proj + (size_t)t * NPROJ + 1024 + c8);
            u32x4 w; w.x = pk2(accv[0] * blo(bv.x), accv[1] * bhi(bv.x)); w.y = pk2(accv[2] * blo(bv.y), accv[3] * bhi(bv.y));
            w.z = pk2(accv[4] * blo(bv.z), accv[5] * bhi(bv.z)); w.w = pk2(accv[6] * blo(bv.w), accv[7] * bhi(bv.w));
            *(u32x4*)(ycat + (size_t)t * D_ + c8) = w;
        }
    }
}

__device__ __forceinline__ void phase_fixup(const Args& a, const int wave_s) {
    TID_SETUP; const int gt = blockIdx.x * 512 + tid, NGT = gridDim.x * 512;
    unsigned char* ws = a.ws; const float* edge = (const float*)(ws + WS_EDGE); bf16_t* act = (bf16_t*)(ws + WS_ACT); const float* cw = a.in[12];
    for (int i = gt; i < 256 * 2 * 1408; i += NGT) {
        const int cq = i % 1408, rr = (i / 1408) & 1, G = i / 2816;
        const int c = 4 * cq, np = (c >> 7) * 256 + (c & 127);
        f32x4 y[2];
#pragma unroll
        for (int gv = 0; gv < 2; ++gv) {
            const int off = gv * 128, wcol = gv * DFF + c;
            f32x4 em2 = (f32x4){0.f, 0.f, 0.f, 0.f}, em1 = em2;
            if ((G & 63) != 0) { em2 = *(const f32x4*)(edge + ((size_t)(G - 1) * 4 + 0) * NUP + np + off); em1 = *(const f32x4*)(edge + ((size_t)(G - 1) * 4 + 1) * NUP + np + off); }
            const f32x4 e0 = *(const f32x4*)(edge + ((size_t)G * 4 + 2) * NUP + np + off), e1 = *(const f32x4*)(edge + ((size_t)G * 4 + 3) * NUP + np + off);
            const f32x4 w0 = *(const f32x4*)(cw + wcol), w1 = *(const f32x4*)(cw + NUP + wcol), w2 = *(const f32x4*)(cw + 2 * NUP + wcol);
            y[gv] = rr == 0 ? (w0 * em2 + w1 * em1 + w2 * e0) : (w0 * em1 + w1 * e0 + w2 * e1);
        }
        u32x2 w; w.x = pk2(silu_f(y[0][0]) * y[1][0], silu_f(y[0][1]) * y[1][1]); w.y = pk2(silu_f(y[0][2]) * y[1][2], silu_f(y[0][3]) * y[1][3]);
        *(u32x2*)(act + (size_t)(64 * G + rr) * DFF + c) = w;
    }
}
__device__ __forceinline__ void phase_final(const Args& a, const int wave_s) {
    TID_SETUP; const int gt = blockIdx.x * 512 + tid, NGT = gridDim.x * 512;
    const float* rss3 = (const float*)(a.ws + WS_RSS) + 2 * T_; const f32x4* g4 = (const f32x4*)a.in[17]; f32x4* o4 = (f32x4*)a.out; const u32x2* x3 = (const u32x2*)(a.ws + WS_X3B);
    constexpr int N4 = T_ * D_ / 4;
    for (int i0 = gt; i0 < N4; i0 += 4 * NGT) {
        u32x2 xw[4]; float ssv[4]; f32x4 gv[4];
#pragma unroll
        for (int k = 0; k < 4; ++k) { const int i = i0 + k * NGT; if (i < N4) { xw[k] = x3[i]; ssv[k] = rss3[i >> 9]; gv[k] = g4[i & 511]; } }
#pragma unroll
        for (int k = 0; k < 4; ++k) { const int i = i0 + k * NGT; if (i < N4) { const float rs = rsqrtf(ssv[k] * (1.f / D_) + EPS_); const f32x4 g = gv[k];
            f32x4 v; v[0] = blo(xw[k].x) * rs * g[0]; v[1] = bhi(xw[k].x) * rs * g[1]; v[2] = blo(xw[k].y) * rs * g[2]; v[3] = bhi(xw[k].y) * rs * g[3]; o4[i] = v; } }
    }
}

__global__ void __launch_bounds__(512) mega(Args a) {
    extern __shared__ __attribute__((aligned(16))) unsigned char lds_raw[];
    LAS unsigned char* lds = (LAS unsigned char*)lds_raw;
    cg::grid_group grid = cg::this_grid();
    const int wave_s = __builtin_amdgcn_readfirstlane((int)(threadIdx.x >> 6));
    unsigned char* ws = a.ws;
    float* rss = (float*)(ws + WS_RSS);
    unsigned* barw = (unsigned*)(ws + WS_BAR);
    volatile LAS unsigned* xst = (volatile LAS unsigned*)(lds + LDS_BYTES - 16);
    if (wave_s == 0) { const int l0 = lane_opaque(); if (l0 < 4) xst[l0] = 0u; }
    __syncthreads();
    if (wave_s == 0 && lane_opaque() == 0) (void)xb_add(&barw[XB_XCNT(xb_xcc_id())], 1u);
    if (a.ph_hi > 1000) grid.sync();
#define GRID_BAR() xcd_barrier(barw, xst, wave_s == 0 && lane_opaque() == 0)
#ifndef DUP_MASK
#define DUP_MASK 0
#endif
#define PH(i, body) if (a.ph_lo <= (i) && (i) < a.ph_hi) { if ((DUP_MASK >> (i)) & 1) { body; GRID_BAR(); } body; if ((i) + 1 < a.ph_hi) GRID_BAR(); }
    PH(0, phase0(a, lds, wave_s));
    PH(1, phase1(a, lds, wave_s));
    PH(2, phase_chunk(a, lds, wave_s));
    PH(3, phase_scan(a, lds, wave_s));
    PH(4, phase_mix_out(a, wave_s));
    PH(5, { EpiResidual<false> E; E.resf = a.in[0]; E.resb = nullptr; E.outb = (bf16_t*)(ws + WS_X1B); E.rss = rss;
            run_gemm(lds, (const bf16_t*)(ws + WS_YCAT), (const bf16_t*)(ws + WS_WOUT), T_, D_, D_, E, wave_s); });
    PH(6, { EpiUp E; E.act = (bf16_t*)(ws + WS_ACT); E.edge = (float*)(ws + WS_EDGE); E.rss = rss; E.cw = a.in[12];
            run_gemm(lds, (const bf16_t*)(ws + WS_X1B), (const bf16_t*)(ws + WS_WUP), T_, NUP, D_, E, wave_s); });
    PH(7, phase_fixup(a, wave_s));
    PH(8, { EpiResidual<true> E; E.resf = nullptr; E.resb = (const bf16_t*)(ws + WS_X1B); E.outb = (bf16_t*)(ws + WS_X1B); E.rss = rss + T_;
            run_gemm(lds, (const bf16_t*)(ws + WS_ACT), (const bf16_t*)(ws + WS_WDOWN), T_, D_, DFF, E, wave_s); });
    PH(9, { EpiPle E; E.x2b = (const bf16_t*)(ws + WS_X1B); E.x3b = (bf16_t*)(ws + WS_X3B); E.pp = (const bf16_t*)a.out; E.rss2 = rss + T_; E.rss3 = rss + 2 * T_;
            run_gemm(lds, (const bf16_t*)(ws + WS_X1B), (const bf16_t*)(ws + WS_WPG), T_, D_, D_, E, wave_s); });
    PH(10, phase_final(a, wave_s));
#undef PH
}

extern "C" void kernel_launch(void* const* d_in, const int* in_sizes, int n_in, void* d_out, int out_size, void* d_ws, size_t ws_size, hipStream_t stream) {
    static int grid = 0;
    if (grid == 0) {
        if (n_in != 18 || in_sizes[0] != T_ * D_ || out_size != T_ * D_ || ws_size < WS_END) { fprintf(stderr, "kernel_launch: unexpected shapes (n_in %d, ws %zu, need %zu)\n", n_in, ws_size, (size_t)WS_END); grid = -1; return; }
        int dev = 0, cus = 0, per_cu = 0;
        if (hipGetDevice(&dev) != hipSuccess || hipDeviceGetAttribute(&cus, hipDeviceAttributeMultiprocessorCount, dev) != hipSuccess) { grid = -1; return; }
        if (hipFuncSetAttribute((const void*)mega, hipFuncAttributeMaxDynamicSharedMemorySize, LDS_BYTES) != hipSuccess) { fprintf(stderr, "kernel_launch: hipFuncSetAttribute failed\n"); grid = -1; return; }
        if (hipOccupancyMaxActiveBlocksPerMultiprocessor(&per_cu, (const void*)mega, 512, LDS_BYTES) != hipSuccess || per_cu < 1) { fprintf(stderr, "kernel_launch: occupancy query says %d blocks per CU\n", per_cu); per_cu = 1; }
        (void)hipGetLastError();
        grid = cus;
    }
    if (grid < 0) return;
    Args a{};
    for (int i = 0; i < 18; ++i) a.in[i] = (const float*)d_in[i];
    a.out = (float*)d_out; a.ws = (unsigned char*)d_ws; a.ph_lo = 0; a.ph_hi = NPHASE;
    if (hipMemsetAsync((char*)d_ws + WS_BAR, 0, (size_t)XCD_BAR_WORDS * 4, stream) != hipSuccess) { fprintf(stderr, "kernel_launch: memset of the barrier words failed\n"); return; }
    void* args[] = {&a};
    hipError_t e = hipLaunchCooperativeKernel((const void*)mega, dim3(grid), dim3(512), args, LDS_BYTES, stream);
    if (e != hipSuccess) fprintf(stderr, "kernel_launch: cooperative launch failed: %s (grid %d)\n", hipGetErrorString(e), grid);
}
```

```cpp
#include <hip/hip_runtime.h>
#include <hip/hip_cooperative_groups.h>
#include <cstdio>
namespace cg = cooperative_groups;

#define LAS __attribute__((address_space(3)))
typedef unsigned short bf16_t;
typedef short bf16x8 __attribute__((ext_vector_type(8)));
typedef float f32x4 __attribute__((ext_vector_type(4)));
typedef unsigned u32x4 __attribute__((ext_vector_type(4)));
typedef unsigned u32x2 __attribute__((ext_vector_type(2)));

constexpr int T_ = 16384, D_ = 2048, SEQ_ = 4096, NPROJ = 7168, INCOLS = 7184, HD = 128, DFF = 5632, NUP = 11264, PLE_ = 256, NCHUNK = 2048;
constexpr float EPS_ = 1e-6f;
constexpr int LDS_BYTES = 147456;
constexpr int NPHASE = 11;

constexpr size_t WS_WIN = 0;
constexpr size_t WS_WAB = WS_WIN + (size_t)NPROJ * D_ * 2;
constexpr size_t WS_WOUT = WS_WAB + 16 * D_ * 2;
constexpr size_t WS_B = WS_WOUT + (size_t)D_ * D_ * 2;
constexpr size_t WS_PROJ = WS_B + (size_t)T_ * D_ * 2;
constexpr size_t WS_ACT = WS_PROJ;
constexpr size_t WS_X3B = WS_PROJ;
constexpr size_t WS_EDGE = WS_ACT + (size_t)T_ * DFF * 2;
constexpr size_t WS_D = WS_PROJ + (size_t)T_ * NPROJ * 2;
constexpr size_t CH16 = (size_t)NCHUNK * 64 * 128 * 2;
constexpr size_t WS_U = WS_D;
constexpr size_t WS_W = WS_U + CH16;
constexpr size_t WS_QD = WS_W + CH16;
constexpr size_t WS_KDT = WS_QD + CH16;
constexpr size_t WS_QK = WS_KDT + CH16;
constexpr size_t WS_O = WS_QK + (size_t)NCHUNK * 64 * 64 * 2;
constexpr size_t WS_DEND = WS_O + (size_t)T_ * 1024 * 2;
constexpr size_t WS_YCAT = WS_D;
constexpr size_t WS_PP = WS_D;
constexpr size_t WS_X1B = WS_D + (size_t)T_ * D_ * 2;
constexpr size_t WS_WUP = WS_B;
constexpr size_t WS_WPG = WS_WUP + (size_t)NUP * D_ * 2;
constexpr size_t WS_LATE_END = WS_WPG + (size_t)D_ * D_ * 2;
constexpr size_t WS_WDOWN = WS_WIN;
static_assert(WS_LATE_END <= WS_PROJ, "late weights overflow region B");
static_assert((size_t)D_ * DFF * 2 <= (size_t)NPROJ * D_ * 2, "w_down copy overflow");
static_assert(WS_X1B + (size_t)T_ * D_ * 2 <= WS_O, "x1b overlaps O");
static_assert(WS_EDGE + (size_t)256 * 4 * NUP * 4 <= WS_D, "edge overflow");
constexpr size_t WS_AB = WS_DEND;
constexpr size_t WS_RSS = WS_AB + (size_t)T_ * 16 * 4;
constexpr size_t WS_PB = WS_RSS + (size_t)3 * T_ * 4;
constexpr size_t WS_GL = WS_PB + (size_t)T_ * PLE_ * 2;
constexpr size_t WS_BAR = WS_GL + NCHUNK * 4;
constexpr int XCD_BAR_WORDS = 3456;
constexpr size_t WS_WPP = (WS_BAR + (size_t)XCD_BAR_WORDS * 4 + 255) / 256 * 256;
constexpr size_t WS_END = WS_WPP + (size_t)D_ * PLE_ * 2;
static_assert(WS_END <= (size_t)512 * 1024 * 1024, "workspace exceeds 512 MiB");

struct Args { const float* in[18]; float* out; unsigned char* ws; int ph_lo, ph_hi; };

typedef __bf16 bf16x2_t __attribute__((ext_vector_type(2)));
typedef float f32x2_t __attribute__((ext_vector_type(2)));
__device__ __forceinline__ unsigned pk2(float lo, float hi) { f32x2_t v = {lo, hi}; bf16x2_t b = __builtin_convertvector(v, bf16x2_t); return __builtin_bit_cast(unsigned, b); }
__device__ __forceinline__ bf16_t f2b(float x) { return (bf16_t)(pk2(x, 0.f) & 0xffffu); }
__device__ __forceinline__ float b2f(bf16_t v) { return __uint_as_float((unsigned)v << 16); }
__device__ __forceinline__ float blo(unsigned v) { return __uint_as_float(v << 16); }
__device__ __forceinline__ float bhi(unsigned v) { return __uint_as_float(v & 0xffff0000u); }
__device__ __forceinline__ float silu_f(float x) { return x * __builtin_amdgcn_rcpf(1.f + __expf(-x)); }
__device__ __forceinline__ float sigmoid_f(float x) { return __builtin_amdgcn_rcpf(1.f + __expf(-x)); }
template <int CTRL> __device__ __forceinline__ float dpp_rot(float v) { return __int_as_float(__builtin_amdgcn_mov_dpp(__float_as_int(v), CTRL, 0xF, 0xF, true)); }
template <int CTRL, int ROWMASK> __device__ __forceinline__ float dpp_f(float v) { return __int_as_float(__builtin_amdgcn_update_dpp(0, __float_as_int(v), CTRL, ROWMASK, 0xF, false)); }
__device__ __forceinline__ float wave_sum(float v) {
    v += dpp_rot<0xB1>(v); v += dpp_rot<0x4E>(v); v += dpp_rot<0x141>(v); v += dpp_rot<0x140>(v);
    v += dpp_f<0x142, 0xA>(v); v += dpp_f<0x143, 0xC>(v);
    return __int_as_float(__builtin_amdgcn_readlane(__float_as_int(v), 63));
}
__device__ __forceinline__ int lane_opaque() { int l; asm volatile("v_mbcnt_lo_u32_b32 %0, -1, 0\n\tv_mbcnt_hi_u32_b32 %0, -1, %0" : "=v"(l)); return l; }
#define TID_SETUP const int lane = lane_opaque(); const int tid = wave_s * 64 + lane; const int wave = wave_s; (void)wave; (void)lane
__device__ __forceinline__ float bperm(float v, int byteaddr) { return __int_as_float(__builtin_amdgcn_ds_bpermute(byteaddr, __float_as_int(v))); }
#define LDS_WAIT() asm volatile("s_waitcnt lgkmcnt(0)" ::: "memory")


#define XB_TMO      128
#define XB_XCNT(j)  (256  + 64 * (j))
#define XB_XSUB(j)  (1280 + 64 * (j))
#define XB_XGEN(j)  (2304 + 64 * (j))
#define XB_TOP      3328
#define XB_TOPGEN   3392
#define XB_SPIN_CAP (1u << 22)
__device__ __forceinline__ unsigned xb_ld(unsigned* p)              { return __hip_atomic_load(p, __ATOMIC_RELAXED, __HIP_MEMORY_SCOPE_AGENT); }
__device__ __forceinline__ unsigned xb_add(unsigned* p, unsigned v) { return __hip_atomic_fetch_add(p, v, __ATOMIC_RELAXED, __HIP_MEMORY_SCOPE_AGENT); }
__device__ __forceinline__ unsigned xb_xcc_id() { return (unsigned)__builtin_amdgcn_s_getreg((3 << 11) | 20) & 0xFu; }
#define XB_SPIN(cond, bar) do { unsigned _sp = 0; while (cond) { __builtin_amdgcn_s_sleep(1); \
    if ((++_sp & 255u) == 0u) { if (xb_ld(&(bar)[XB_TMO])) break; if (_sp > XB_SPIN_CAP) { atomicAdd(&(bar)[XB_TMO], 1u); break; } } } } while (0)
__device__ __forceinline__ void xcd_barrier_complete(unsigned* bar, unsigned x, unsigned& nloc, unsigned& nx) {
    const unsigned G = gridDim.x;
    unsigned sum, cnt, mine, sp = 0u;
    for (;;) {
        sum = 0u; cnt = 0u; mine = 0u;
#pragma unroll
        for (unsigned j = 0; j < 16; ++j) { const unsigned c = xb_ld(&bar[XB_XCNT(j)]); sum += c; cnt += (c > 0u) ? 1u : 0u; mine = (j == x) ? c : mine; }
        if (sum == G) break;
        __builtin_amdgcn_s_sleep(1);
        if ((++sp & 255u) == 0u) { if (xb_ld(&bar[XB_TMO])) break; if (sp > XB_SPIN_CAP) { atomicAdd(&bar[XB_TMO], 1u); break; } }
    }
    nloc = mine > 0u ? mine : 1u; nx = cnt > 0u ? cnt : 1u;
}
__device__ __forceinline__ void xcd_barrier(unsigned* bar, volatile LAS unsigned* st, const bool leader) {
    asm volatile("s_waitcnt vmcnt(0)" ::: "memory");
    __syncthreads();
    if (leader) {
        const unsigned x = xb_xcc_id();
        __builtin_amdgcn_s_waitcnt(0);
        unsigned nloc = st[0], nx = st[1];
        if (nloc == 0u) { xcd_barrier_complete(bar, x, nloc, nx); st[0] = nloc; st[1] = nx; }
        const unsigned old = xb_add(&bar[XB_XSUB(x)], 1u);
        const unsigned gen = old / nloc;
        if (old + 1u == (gen + 1u) * nloc) {
            __builtin_amdgcn_fence(__ATOMIC_RELEASE, "agent");
            asm volatile("s_waitcnt vmcnt(0)" ::: "memory");
            const unsigned og = xb_add(&bar[XB_TOP], 1u);
            const unsigned tg = og / nx;
            if (og + 1u == (tg + 1u) * nx) xb_add(&bar[XB_TOPGEN], 1u);
            else XB_SPIN(xb_ld(&bar[XB_TOPGEN]) == tg, bar);
            __builtin_amdgcn_fence(__ATOMIC_ACQUIRE, "agent");
            xb_add(&bar[XB_XGEN(x)], 1u);
            asm volatile("s_waitcnt vmcnt(0)" ::: "memory");
        } else {
            XB_SPIN(xb_ld(&bar[XB_XGEN(x)]) == gen, bar);
            __builtin_amdgcn_fence(__ATOMIC_ACQUIRE, "agent");
            asm volatile("s_waitcnt vmcnt(0)" ::: "memory");
        }
    }
    __syncthreads();
}

namespace pg8 {
constexpr int BM = 256, BK = 64, HALF = 128, HTB = HALF * BK * 2, STAGE_BYTES = 8 * HTB, NXCD = 8, WGM = 8;
__host__ __device__ __forceinline__ int lds_byte(int r, int c) { const int st = (r >> 4) * 2 + (c >> 5), rr = r & 15, cc = c & 31, ob = rr * 64 + cc * 2; return st * 1024 + (ob ^ (((ob >> 9) & 1) << 5)); }
__host__ __device__ __forceinline__ void stage_rc(int b, int& R, int& C) { const int st = b / 1024, sb = b % 1024, swz = sb ^ (((sb >> 9) & 1) << 5); R = (st >> 1) * 16 + swz / 64; C = (st & 1) * 32 + (swz % 64) / 2; }
__host__ __device__ __forceinline__ int perm32(int rho) { const int n = rho >> 4, i = rho & 15; return 8 * (i >> 2) + 4 * n + (i & 3); }
struct Unit { int pm, pn; };
struct Gemm { const bf16_t* A; const bf16_t* Bt; int M, N, K; };
struct StaticOrder {
    int nM, nN, nwg, G, c;
    __host__ __device__ void init(int M, int N, int G_, int c_) { nM = M / BM; nN = N / BM; nwg = nM * nN; G = G_; c = c_; }
    __host__ __device__ bool next(int i, Unit& u) const {
        const long L = (long)i * G + c; if (L >= nwg) return false;
        int wgid = (int)L; { const int q = nwg / NXCD, r = nwg % NXCD, xcd = wgid % NXCD, off = wgid / NXCD; wgid = (xcd < r ? xcd * (q + 1) : r * (q + 1) + (xcd - r) * q) + off; }
        const int nig = WGM * nN, gid = wgid / nig, fm = gid * WGM, gsz = (nM - fm) < WGM ? (nM - fm) : WGM;
        u.pm = fm + ((wgid % nig) % gsz); u.pn = (wgid % nig) / gsz; return true;
    }
};
template <class Epi>
__device__ __forceinline__ void gemm_phase(LAS unsigned char* lds, const Gemm g, const StaticOrder& S, const Epi& E, const int wave_s) {
    const int lane = lane_opaque(), tid = wave_s * 64 + lane, wid = wave_s, wr = wid >> 2, wc = wid & 3, fr = lane & 15, fq = lane >> 4;
    const int K = g.K, nt = K / BK;
    unsigned voffA[2], voffB[2];
#pragma unroll
    for (int i = 0; i < 2; ++i) { int R, C; stage_rc(tid * 16 + i * 8192, R, C); const int Rb = Epi::PERM ? ((R & ~31) + perm32(R & 31)) : R;
        const int Ra = Epi::PERM_A ? ((R & ~63) + 4 * (R & 15) + ((R >> 4) & 3)) : R;
        voffA[i] = (unsigned)(Ra * K + C) * 2u; voffB[i] = (unsigned)(Rb * K + C) * 2u; }
    const size_t kstep = (size_t)(BK * 2);
    const size_t hstep = (size_t)HALF * K * 2;
    const size_t tstep = 2 * hstep;
    const unsigned ldsw = (unsigned)wid * 1024u;
    const int aoff = lds_byte(wr * 64 + fr, fq * 8), boff = lds_byte(wc * 32 + fr, fq * 8);
#define PG8_SA(b, h) (((b) * 2 + (h)) * HTB)
#define PG8_SB(b, h) ((4 + (b) * 2 + (h)) * HTB)
#define PG8_STAGE(bufoff, gbase, voff) do { _Pragma("unroll") for (int _i = 0; _i < 2; ++_i) \
        __builtin_amdgcn_global_load_lds((const unsigned*)((const char*)(gbase) + (voff)[_i]), (LAS unsigned*)(lds + (bufoff) + ldsw + _i * 8192), 16, 0, 0); } while (0)
#define PG8_LDA(dst, b, h) do { _Pragma("unroll") for (int m = 0; m < 4; ++m) _Pragma("unroll") for (int k = 0; k < 2; ++k) dst[m][k] = *(const LAS bf16x8*)(lds + PG8_SA(b, h) + aoff + m * 2048 + k * 1024); } while (0)
#define PG8_LDB(dst, b, h) do { _Pragma("unroll") for (int n = 0; n < 2; ++n) _Pragma("unroll") for (int k = 0; k < 2; ++k) dst[n][k] = *(const LAS bf16x8*)(lds + PG8_SB(b, h) + boff + n * 2048 + k * 1024); } while (0)
#define PG8_MMA(ai, bj, At, Bt) do { __builtin_amdgcn_s_setprio(1); _Pragma("unroll") for (int m = 0; m < 4; ++m) _Pragma("unroll") for (int n = 0; n < 2; ++n) _Pragma("unroll") for (int k = 0; k < 2; ++k) \
        acc[ai][bj][m][n] = __builtin_amdgcn_mfma_f32_16x16x32_bf16(Bt[n][k], At[m][k], acc[ai][bj][m][n], 0, 0, 0); __builtin_amdgcn_s_setprio(0); } while (0)
#define PG8_WAIT_V(n) asm volatile("s_waitcnt vmcnt(" #n ")" ::: "memory")
#define PG8_WAIT_L(n) asm volatile("s_waitcnt lgkmcnt(" #n ")" ::: "memory")
#define PG8_BAR __builtin_amdgcn_s_barrier()
#define PG8_SCHED __builtin_amdgcn_sched_barrier(0)
    Unit cur, nxt; int ui = 0;
    if (!S.next(0, cur)) return;
    f32x4 acc[2][2][4][2];
#pragma unroll
    for (int a = 0; a < 2; ++a)
#pragma unroll
        for (int b = 0; b < 2; ++b)
#pragma unroll
            for (int m = 0; m < 4; ++m)
#pragma unroll
                for (int n = 0; n < 2; ++n) acc[a][b][m][n] = (f32x4){0.f, 0.f, 0.f, 0.f};
    bf16x8 At[4][2], B0[2][2], B1[2][2];
    const char* cA = (const char*)g.A + (size_t)cur.pm * tstep; const char* cB = (const char*)g.Bt + (size_t)cur.pn * tstep;
    PG8_STAGE(PG8_SB(0, 0), cB, voffB); PG8_STAGE(PG8_SA(0, 0), cA, voffA); PG8_STAGE(PG8_SB(0, 1), cB + hstep, voffB); PG8_STAGE(PG8_SA(0, 1), cA + hstep, voffA);
    if (wr == 1) PG8_BAR;
    PG8_WAIT_V(4); PG8_BAR;
    PG8_STAGE(PG8_SB(1, 0), cB + kstep, voffB); PG8_STAGE(PG8_SA(1, 0), cA + kstep, voffA); PG8_STAGE(PG8_SB(1, 1), cB + hstep + kstep, voffB);
    PG8_WAIT_V(6); PG8_BAR;
    for (;;) {
        const bool has_next = S.next(ui + 1, nxt);
        const char* nA = has_next ? (const char*)g.A + (size_t)nxt.pm * tstep : cA; const char* nB = has_next ? (const char*)g.Bt + (size_t)nxt.pn * tstep : cB;
        for (int t = 0; t < nt; t += 2) {
            const bool last = (t == nt - 2);
            const char* a1 = cA + (size_t)(t + 1) * kstep;
            const char* a2 = last ? nA : cA + (size_t)(t + 2) * kstep; const char* b2 = last ? nB : cB + (size_t)(t + 2) * kstep;
            const char* a3 = a2 + kstep; const char* b3 = b2 + kstep;
            PG8_LDB(B0, 0, 0); PG8_SCHED; PG8_LDA(At, 0, 0); PG8_STAGE(PG8_SA(1, 1), a1 + hstep, voffA);
            PG8_WAIT_L(8); PG8_BAR; PG8_WAIT_L(0); PG8_MMA(0, 0, At, B0); PG8_BAR; PG8_SCHED;
            PG8_LDB(B1, 0, 1); PG8_STAGE(PG8_SB(0, 0), b2, voffB);
            PG8_BAR; PG8_WAIT_L(0); PG8_MMA(0, 1, At, B1); PG8_BAR;
            PG8_LDA(At, 0, 1); PG8_STAGE(PG8_SA(0, 0), a2, voffA);
            PG8_BAR; PG8_WAIT_L(0); PG8_MMA(1, 0, At, B0); PG8_BAR; PG8_SCHED;
            PG8_STAGE(PG8_SB(0, 1), b2 + hstep, voffB);
            PG8_WAIT_V(6); PG8_BAR; PG8_MMA(1, 1, At, B1); PG8_BAR;
            PG8_LDB(B0, 1, 0); PG8_SCHED; PG8_LDA(At, 1, 0); PG8_STAGE(PG8_SA(0, 1), a2 + hstep, voffA);
            PG8_WAIT_L(8); PG8_BAR; PG8_WAIT_L(0); PG8_MMA(0, 0, At, B0); PG8_BAR; PG8_SCHED;
            PG8_LDB(B1, 1, 1); PG8_STAGE(PG8_SB(1, 0), b3, voffB);
            PG8_BAR; PG8_WAIT_L(0); PG8_MMA(0, 1, At, B1); PG8_BAR;
            PG8_LDA(At, 1, 1); PG8_STAGE(PG8_SA(1, 0), a3, voffA);
            PG8_BAR; PG8_WAIT_L(0); PG8_MMA(1, 0, At, B0); PG8_BAR; PG8_SCHED;
            PG8_STAGE(PG8_SB(1, 1), b3 + hstep, voffB);
            PG8_WAIT_V(6); PG8_BAR; PG8_MMA(1, 1, At, B1); PG8_BAR;
        }
        E(acc, cur, wr, wc, fr, fq);
        if (!has_next) break;
#pragma unroll
        for (int a = 0; a < 2; ++a)
#pragma unroll
            for (int b = 0; b < 2; ++b)
#pragma unroll
                for (int m = 0; m < 4; ++m)
#pragma unroll
                    for (int n = 0; n < 2; ++n) acc[a][b][m][n] = (f32x4){0.f, 0.f, 0.f, 0.f};
        cur = nxt; cA = nA; cB = nB; ++ui;
    }
    PG8_WAIT_V(0);
    if (wr == 0) PG8_BAR;
    PG8_BAR;
#undef PG8_SA
#undef PG8_SB
#undef PG8_STAGE
#undef PG8_LDA
#undef PG8_LDB
#undef PG8_MMA
#undef PG8_WAIT_V
#undef PG8_WAIT_L
#undef PG8_BAR
#undef PG8_SCHED
}
}
using pg8::Unit;
typedef const f32x4 (&AccRef)[2][2][4][2];

struct EpiBf16Store {
    static constexpr bool PERM = true, PERM_A = false;
    bf16_t* O; int ldc;
    __device__ __forceinline__ void operator()(AccRef acc, const Unit& u, int wr, int wc, int fr, int fq) const {
        { const int l_ = lane_opaque(); fr = l_ & 15; fq = l_ >> 4; }
        const int row0 = u.pm * 256 + wr * 64 + fr, col0 = u.pn * 256 + wc * 32 + 8 * fq;
#pragma unroll
        for (int ai = 0; ai < 2; ++ai)
#pragma unroll
            for (int m = 0; m < 4; ++m) { bf16_t* rowp = O + (size_t)(row0 + ai * 128 + m * 16) * ldc + col0;
#pragma unroll
                for (int bj = 0; bj < 2; ++bj) { const f32x4 v0 = acc[ai][bj][m][0], v1 = acc[ai][bj][m][1];
                    u32x4 w; w.x = pk2(v0[0], v0[1]); w.y = pk2(v0[2], v0[3]); w.z = pk2(v1[0], v1[1]); w.w = pk2(v1[2], v1[3]); *(u32x4*)(rowp + bj * 128) = w; } }
    }
};
template <bool RES_BF16> struct EpiResidual {
    static constexpr bool PERM = true, PERM_A = false;
    const float* resf; const bf16_t* resb; bf16_t* outb; float* rss;
    __device__ __forceinline__ void operator()(AccRef acc, const Unit& u, int wr, int wc, int fr, int fq) const {
        { const int l_ = lane_opaque(); fr = l_ & 15; fq = l_ >> 4; }
        const int row0 = u.pm * 256 + wr * 64 + fr, col0 = u.pn * 256 + wc * 32 + 8 * fq;
#pragma unroll
        for (int ai = 0; ai < 2; ++ai) {
            u32x4 rb[4][2]; f32x4 rf[4][2][2];
#pragma unroll
            for (int m = 0; m < 4; ++m)
#pragma unroll
                for (int bj = 0; bj < 2; ++bj) { const size_t o = (size_t)(row0 + ai * 128 + m * 16) * D_ + col0 + bj * 128;
                    if (RES_BF16) rb[m][bj] = *(const u32x4*)(resb + o); else { rf[m][bj][0] = *(const f32x4*)(resf + o); rf[m][bj][1] = *(const f32x4*)(resf + o + 4); } }
            __builtin_amdgcn_sched_barrier(0);
#pragma unroll
            for (int m = 0; m < 4; ++m) { const int row = row0 + ai * 128 + m * 16; const size_t ro = (size_t)row * D_ + col0; float ss = 0.f;
#pragma unroll
                for (int bj = 0; bj < 2; ++bj) { const size_t o = ro + bj * 128; f32x4 r0, r1;
                    if (RES_BF16) { const u32x4 rw = rb[m][bj]; r0[0] = blo(rw.x); r0[1] = bhi(rw.x); r0[2] = blo(rw.y); r0[3] = bhi(rw.y); r1[0] = blo(rw.z); r1[1] = bhi(rw.z); r1[2] = blo(rw.w); r1[3] = bhi(rw.w); }
                    else { r0 = rf[m][bj][0]; r1 = rf[m][bj][1]; }
                    const f32x4 v0 = acc[ai][bj][m][0] + r0, v1 = acc[ai][bj][m][1] + r1;
                    u32x4 w; w.x = pk2(v0[0], v0[1]); w.y = pk2(v0[2], v0[3]); w.z = pk2(v1[0], v1[1]); w.w = pk2(v1[2], v1[3]); *(u32x4*)(outb + o) = w;
                    ss += v0[0] * v0[0] + v0[1] * v0[1] + v0[2] * v0[2] + v0[3] * v0[3] + v1[0] * v1[0] + v1[1] * v1[1] + v1[2] * v1[2] + v1[3] * v1[3]; }
                ss += __shfl_xor(ss, 16); ss += __shfl_xor(ss, 32);
                if (fq == 0) atomicAdd(rss + row, ss); }
        }
    }
};
__device__ __forceinline__ f32x4 silu4(const f32x4 x) {
    const f32x4 t = x * (-1.4426950408889634f); f32x4 e; e[0] = __builtin_amdgcn_exp2f(t[0]); e[1] = __builtin_amdgcn_exp2f(t[1]); e[2] = __builtin_amdgcn_exp2f(t[2]); e[3] = __builtin_amdgcn_exp2f(t[3]);
    const f32x4 d = e + 1.0f; f32x4 rc; rc[0] = __builtin_amdgcn_rcpf(d[0]); rc[1] = __builtin_amdgcn_rcpf(d[1]); rc[2] = __builtin_amdgcn_rcpf(d[2]); rc[3] = __builtin_amdgcn_rcpf(d[3]);
    return x * rc;
}
__device__ __forceinline__ f32x4 ror1_4(const f32x4 v) { f32x4 r; r[0] = dpp_rot<0x121>(v[0]); r[1] = dpp_rot<0x121>(v[1]); r[2] = dpp_rot<0x121>(v[2]); r[3] = dpp_rot<0x121>(v[3]); return r; }
struct EpiUp {
    static constexpr bool PERM = false, PERM_A = true;
    bf16_t* act; float* edge; const float* rss; const float* cw;
    __device__ __forceinline__ void operator()(AccRef acc, const Unit& u, int wr, int wc, int fr, int fq) const {
        { const int l_ = lane_opaque(); fr = l_ & 15; fq = l_ >> 4; }
#pragma unroll
        for (int ai = 0; ai < 2; ++ai) {
            const int rowg = u.pm * 256 + ai * 128 + wr * 64;
            const int row0 = rowg + 4 * fr;
            float rs[4];
#pragma unroll
            for (int m = 0; m < 4; ++m) rs[m] = rsqrtf(rss[row0 + m] * (1.f / D_) + EPS_);
            float* eg = edge + (size_t)(rowg >> 6) * 4 * NUP;
#pragma unroll
            for (int n = 0; n < 2; ++n) {
                const int cin = wc * 32 + n * 16 + 4 * fq;
                const int colg = u.pn * 128 + cin;
                const int np = u.pn * 256 + cin;
                f32x4 sg[4];
                {
                    const f32x4 w0 = *(const f32x4*)(cw + colg), w1 = *(const f32x4*)(cw + NUP + colg), w2 = *(const f32x4*)(cw + 2 * NUP + colg);
                    const f32x4 g0 = acc[ai][0][0][n] * rs[0], g1 = acc[ai][0][1][n] * rs[1], g2 = acc[ai][0][2][n] * rs[2], g3 = acc[ai][0][3][n] * rs[3];
                    const f32x4 p3 = ror1_4(g3), p2 = ror1_4(g2);
                    sg[0] = silu4(w0 * p2 + w1 * p3 + w2 * g0);
                    sg[1] = silu4(w0 * p3 + w1 * g0 + w2 * g1);
                    sg[2] = silu4(w0 * g0 + w1 * g1 + w2 * g2);
                    sg[3] = silu4(w0 * g1 + w1 * g2 + w2 * g3);
                    if (fr == 0) { *(f32x4*)(eg + 2 * NUP + np) = g0; *(f32x4*)(eg + 3 * NUP + np) = g1; }
                    if (fr == 15) { *(f32x4*)(eg + np) = g2; *(f32x4*)(eg + NUP + np) = g3; }
                    __builtin_amdgcn_sched_barrier(0);
                }
                {
                    const f32x4 w0 = *(const f32x4*)(cw + DFF + colg), w1 = *(const f32x4*)(cw + NUP + DFF + colg), w2 = *(const f32x4*)(cw + 2 * NUP + DFF + colg);
                    const f32x4 v0 = acc[ai][1][0][n] * rs[0], v1 = acc[ai][1][1][n] * rs[1], v2 = acc[ai][1][2][n] * rs[2], v3 = acc[ai][1][3][n] * rs[3];
                    const f32x4 p3 = ror1_4(v3), p2 = ror1_4(v2);
                    f32x4 r[4];
                    r[0] = sg[0] * (w0 * p2 + w1 * p3 + w2 * v0);
                    r[1] = sg[1] * (w0 * p3 + w1 * v0 + w2 * v1);
                    r[2] = sg[2] * (w0 * v0 + w1 * v1 + w2 * v2);
                    r[3] = sg[3] * (w0 * v1 + w1 * v2 + w2 * v3);
#pragma unroll
                    for (int m = 0; m < 4; ++m)
                        if (!(m < 2 && fr == 0)) { u32x2 w; w.x = pk2(r[m][0], r[m][1]); w.y = pk2(r[m][2], r[m][3]); *(u32x2*)(act + (size_t)(row0 + m) * DFF + colg) = w; }
                    if (fr == 0) { *(f32x4*)(eg + 2 * NUP + np + 128) = v0; *(f32x4*)(eg + 3 * NUP + np + 128) = v1; }
                    if (fr == 15) { *(f32x4*)(eg + np + 128) = v2; *(f32x4*)(eg + NUP + np + 128) = v3; }
                    __builtin_amdgcn_sched_barrier(0);
                }
            }
        }
    }
};
struct EpiPle {
    static constexpr bool PERM = true, PERM_A = false;
    const bf16_t* x2b; bf16_t* x3b; const bf16_t* pp; const float* rss2; float* rss3;
    __device__ __forceinline__ void operator()(AccRef acc, const Unit& u, int wr, int wc, int fr, int fq) const {
        { const int l_ = lane_opaque(); fr = l_ & 15; fq = l_ >> 4; }
        const int row0 = u.pm * 256 + wr * 64 + fr, col0 = u.pn * 256 + wc * 32 + 8 * fq;
#pragma unroll
        for (int ai = 0; ai < 2; ++ai) {
            u32x4 xb[4][2], pb[4][2]; float rsv[4];
#pragma unroll
            for (int m = 0; m < 4; ++m) { rsv[m] = rss2[row0 + ai * 128 + m * 16];
#pragma unroll
                for (int bj = 0; bj < 2; ++bj) { const size_t o = (size_t)(row0 + ai * 128 + m * 16) * D_ + col0 + bj * 128; xb[m][bj] = *(const u32x4*)(x2b + o); pb[m][bj] = *(const u32x4*)(pp + o); } }
            __builtin_amdgcn_sched_barrier(0);
#pragma unroll
            for (int m = 0; m < 4; ++m) { const int row = row0 + ai * 128 + m * 16; const size_t ro = (size_t)row * D_ + col0; float ss = 0.f;
                const float rs = rsqrtf(rsv[m] * (1.f / D_) + EPS_);
#pragma unroll
                for (int bj = 0; bj < 2; ++bj) { const size_t o = ro + bj * 128; const f32x4 a0 = acc[ai][bj][m][0] * rs, a1 = acc[ai][bj][m][1] * rs;
                    const u32x4 xw = xb[m][bj], pw = pb[m][bj];
                    f32x4 v0, v1;
                    v0[0] = blo(xw.x) + sigmoid_f(a0[0]) * blo(pw.x); v0[1] = bhi(xw.x) + sigmoid_f(a0[1]) * bhi(pw.x); v0[2] = blo(xw.y) + sigmoid_f(a0[2]) * blo(pw.y); v0[3] = bhi(xw.y) + sigmoid_f(a0[3]) * bhi(pw.y);
                    v1[0] = blo(xw.z) + sigmoid_f(a1[0]) * blo(pw.z); v1[1] = bhi(xw.z) + sigmoid_f(a1[1]) * bhi(pw.z); v1[2] = blo(xw.w) + sigmoid_f(a1[2]) * blo(pw.w); v1[3] = bhi(xw.w) + sigmoid_f(a1[3]) * bhi(pw.w);
                    u32x4 w; w.x = pk2(v0[0], v0[1]); w.y = pk2(v0[2], v0[3]); w.z = pk2(v1[0], v1[1]); w.w = pk2(v1[2], v1[3]); *(u32x4*)(x3b + o) = w;
                    ss += v0[0] * v0[0] + v0[1] * v0[1] + v0[2] * v0[2] + v0[3] * v0[3] + v1[0] * v1[0] + v1[1] * v1[1] + v1[2] * v1[2] + v1[3] * v1[3]; }
                ss += __shfl_xor(ss, 16); ss += __shfl_xor(ss, 32);
                if (fq == 0) atomicAdd(rss3 + row, ss); }
        }
    }
};
template <class Epi> __device__ __forceinline__ void run_gemm_sub(LAS unsigned char* lds, const bf16_t* A, const bf16_t* Bt, int M, int N, int K, const Epi& E, const int wave_s, const int G, const int c) {
    pg8::Gemm g; g.A = A; g.Bt = Bt; g.M = M; g.N = N; g.K = K; pg8::StaticOrder S; S.init(M, N, G, c); pg8::gemm_phase(lds, g, S, E, wave_s);
}
template <class Epi> __device__ __forceinline__ void run_gemm(LAS unsigned char* lds, const bf16_t* A, const bf16_t* Bt, int M, int N, int K, const Epi& E, const int wave_s) {
    pg8::Gemm g; g.A = A; g.Bt = Bt; g.M = M; g.N = N; g.K = K; pg8::StaticOrder S; S.init(M, N, (int)gridDim.x, (int)blockIdx.x); pg8::gemm_phase(lds, g, S, E, wave_s);
}

struct TItem { const float* W; int K, N, k0, n0; bf16_t* WT; int drow0; const float* gk; };
__device__ __forceinline__ void transpose_load(const TItem& t, float (&tv)[32], int lane) {
#pragma unroll
    for (int i = 0; i < 32; ++i) tv[i] = t.W[(size_t)(t.k0 + 2 * i + (lane >> 5)) * t.N + t.n0 + (lane & 31)];
}
__device__ __forceinline__ void transpose_store(const TItem& t, const float (&tv)[32], LAS float* scr, int lane) {
#pragma unroll
    for (int i = 0; i < 32; ++i) { const int kk = 2 * i + (lane >> 5); float v = tv[i]; if (t.gk) v *= t.gk[t.k0 + kk]; scr[kk * 33 + (lane & 31)] = v; }
    LDS_WAIT();
    const int c = lane & 7;
#pragma unroll
    for (int j = 0; j < 4; ++j) { const int n = (lane >> 3) + 8 * j; const LAS float* s = scr + (8 * c) * 33 + n;
        u32x4 o; o.x = pk2(s[0 * 33], s[1 * 33]); o.y = pk2(s[2 * 33], s[3 * 33]); o.z = pk2(s[4 * 33], s[5 * 33]); o.w = pk2(s[6 * 33], s[7 * 33]);
        *(u32x4*)(t.WT + (size_t)(t.drow0 + n) * t.K + t.k0 + 8 * c) = o; }
    LDS_WAIT();
}
__device__ __forceinline__ TItem early_item(const Args& a, unsigned char* ws, int it) {
    constexpr int I_IN = 32 * 224, I_OUT = 32 * 64; TItem t; t.gk = nullptr;
    if (it < I_IN) { const int kb = it / 224, nb = it % 224; t.W = a.in[3]; t.K = D_; t.N = INCOLS; t.k0 = 64 * kb; t.n0 = 32 * nb; t.WT = (bf16_t*)(ws + WS_WIN); t.drow0 = 32 * nb; }
    else if (it < I_IN + I_OUT) { const int r = it - I_IN, kb = r / 64, nb = r % 64; t.W = a.in[9]; t.K = D_; t.N = D_; t.k0 = 64 * kb; t.n0 = 32 * nb; t.WT = (bf16_t*)(ws + WS_WOUT); t.drow0 = 32 * nb; }
    else { const int r = it - I_IN - I_OUT, kb = r / 64, nb = r % 64; t.W = a.in[16]; t.K = PLE_; t.N = D_; t.k0 = 64 * kb; t.n0 = 32 * nb; t.WT = (bf16_t*)(ws + WS_WPP); t.drow0 = 32 * nb; }
    return t;
}
__device__ __forceinline__ TItem late_item(const Args& a, unsigned char* ws, int it) {
    constexpr int I_UP = 32 * 352, I_DN = 88 * 64; TItem t;
    if (it < I_UP) { const int kb = it / 352, nb = it % 352, n0 = 32 * nb; t.W = a.in[11]; t.K = D_; t.N = NUP; t.k0 = 64 * kb; t.n0 = n0; t.WT = (bf16_t*)(ws + WS_WUP);
        t.drow0 = n0 < DFF ? (n0 / 128) * 256 + (n0 % 128) : ((n0 - DFF) / 128) * 256 + 128 + ((n0 - DFF) % 128); t.gk = a.in[10]; }
    else if (it < I_UP + I_DN) { const int r = it - I_UP, kb = r / 64, nb = r % 64; t.W = a.in[13]; t.K = DFF; t.N = D_; t.k0 = 64 * kb; t.n0 = 32 * nb; t.WT = (bf16_t*)(ws + WS_WDOWN); t.drow0 = 32 * nb; t.gk = nullptr; }
    else { const int r = it - I_UP - I_DN, kb = r / 64, nb = r % 64; t.W = a.in[15]; t.K = D_; t.N = D_; t.k0 = 64 * kb; t.n0 = 32 * nb; t.WT = (bf16_t*)(ws + WS_WPG); t.drow0 = 32 * nb; t.gk = a.in[14]; }
    return t;
}
template <bool LATE> __device__ __forceinline__ void transpose_items(const Args& a, unsigned char* ws, LAS float* scr, int lane, int first, int step, int total) {
    if (first >= total) return;
    TItem cur = LATE ? late_item(a, ws, first) : early_item(a, ws, first);
    float tv[32]; transpose_load(cur, tv, lane);
    for (int it = first; it < total; it += step) {
        const int nit = it + step; TItem nx = cur; float tn[32];
        if (nit < total) { nx = LATE ? late_item(a, ws, nit) : early_item(a, ws, nit); transpose_load(nx, tn, lane); }
        else {
#pragma unroll
            for (int i = 0; i < 32; ++i) tn[i] = 0.f; }
        transpose_store(cur, tv, scr, lane);
        cur = nx;
#pragma unroll
        for (int i = 0; i < 32; ++i) tv[i] = tn[i];
    }
}

__device__ __forceinline__ void phase0(const Args& a, LAS unsigned char* lds, const int wave_s) {
    TID_SETUP;
    const int gw = blockIdx.x * 8 + wave, NGW = gridDim.x * 8, gt = blockIdx.x * 512 + tid, NGT = gridDim.x * 512;
    unsigned char* ws = a.ws;
    float* rss = (float*)(ws + WS_RSS);
    for (int i = gt; i < 3 * T_; i += NGT) rss[i] = 0.f;
    { float* ab0 = (float*)(ws + WS_AB); for (int i = gt; i < T_ * 16; i += NGT) ab0[i] = 0.f; }
    { bf16_t* wab = (bf16_t*)(ws + WS_WAB); const float* w_in = a.in[3];
      for (int i = gt; i < 16 * D_; i += NGT) { const int n = i >> 11, k = i & 2047; wab[i] = f2b(w_in[(size_t)k * INCOLS + NPROJ + n]); } }
    { const f32x4* p4 = (const f32x4*)a.in[1]; u32x2* pb = (u32x2*)(ws + WS_PB);
      for (int i = gt; i < T_ * PLE_ / 4; i += NGT) { const f32x4 v = p4[i]; u32x2 o; o.x = pk2(v[0], v[1]); o.y = pk2(v[2], v[3]); pb[i] = o; } }
    { const float* x = a.in[0]; const f32x4* g4 = (const f32x4*)a.in[2]; bf16_t* hb = (bf16_t*)(ws + WS_B);
      for (int row = gw; row < T_; row += NGW) {
          const f32x4* xr = (const f32x4*)(x + (size_t)row * D_) + lane; f32x4 v[8]; float s = 0.f;
#pragma unroll
          for (int j = 0; j < 8; ++j) { v[j] = xr[64 * j]; s += v[j][0] * v[j][0] + v[j][1] * v[j][1] + v[j][2] * v[j][2] + v[j][3] * v[j][3]; }
          const float rstd = rsqrtf(wave_sum(s) * (1.f / D_) + EPS_);
          u32x2* o8 = (u32x2*)(hb + (size_t)row * D_) + lane;
#pragma unroll
          for (int j = 0; j < 8; ++j) { const f32x4 g = g4[lane + 64 * j]; u32x2 o; o.x = pk2(v[j][0] * rstd * g[0], v[j][1] * rstd * g[1]); o.y = pk2(v[j][2] * rstd * g[2], v[j][3] * rstd * g[3]); o8[64 * j] = o; }
      } }
    { LAS float* scr = (LAS float*)(lds + wave * 8448);
      transpose_items<false>(a, ws, scr, lane, gw, NGW, 32 * 224 + 32 * 64 + 4 * 64); }
}
constexpr int LATE_ITEMS = 32 * 352 + 88 * 64 + 32 * 64;
constexpr int LATE_SPLIT = (LATE_ITEMS * 3 / 4) / 1024 * 1024;
__device__ __forceinline__ void late_weights(const Args& a, LAS unsigned char* lds, const int wave_s, const int blk, const int nblk, const int lo, const int hi) {
    TID_SETUP; (void)tid; const int gw = blk * 8 + wave, NGW = nblk * 8;
    unsigned char* ws = a.ws; LAS float* scr = (LAS float*)(lds + wave * 8448);
    transpose_items<true>(a, ws, scr, lane, lo + gw, NGW, hi);
    __syncthreads();
}

__device__ __forceinline__ void phase1(const Args& a, LAS unsigned char* lds, const int wave_s) {
    TID_SETUP; (void)tid; const int gw = blockIdx.x * 8 + wave, NGW = gridDim.x * 8;
    unsigned char* ws = a.ws; const bf16_t* hb = (const bf16_t*)(ws + WS_B);
    { const bf16_t* wab = (const bf16_t*)(ws + WS_WAB); float* AB = (float*)(ws + WS_AB); const int l15 = lane & 15, q = lane >> 4;
      for (int it2 = gw; it2 < 2 * (T_ / 16); it2 += NGW) {
          const int tt = it2 >> 1, kh = it2 & 1;
          f32x4 acc = (f32x4){0.f, 0.f, 0.f, 0.f};
          const bf16_t* ap = hb + (size_t)(16 * tt + l15) * D_ + 1024 * kh + 8 * q; const bf16_t* bp = wab + (size_t)l15 * D_ + 1024 * kh + 8 * q;
#pragma unroll 16
          for (int ks = 0; ks < 32; ++ks) { const bf16x8 av = *(const bf16x8*)(ap + 32 * ks), bv = *(const bf16x8*)(bp + 32 * ks); acc = __builtin_amdgcn_mfma_f32_16x16x32_bf16(av, bv, acc, 0, 0, 0); }
#pragma unroll
          for (int j = 0; j < 4; ++j) atomicAdd(AB + (size_t)(16 * tt + 4 * q + j) * 16 + l15, acc[j]);
      } }
    EpiBf16Store E; E.O = (bf16_t*)(ws + WS_PROJ); E.ldc = NPROJ;
    run_gemm(lds, hb, (const bf16_t*)(ws + WS_WIN), T_, NPROJ, D_, E, wave_s);
}

template <int I, int JJ> __device__ __forceinline__ void sub_group(float (&Tc)[64], float (&rb)[64], float& s0, float& s1, float& s2, float& s3, const LAS float* LM) {
    if constexpr (4 * JJ < I + 1) {
        if constexpr (4 * JJ + 0 < I) s0 += rb[4 * JJ + 0] * Tc[4 * JJ + 0];
        if constexpr (4 * JJ + 1 < I) s1 += rb[4 * JJ + 1] * Tc[4 * JJ + 1];
        if constexpr (4 * JJ + 2 < I) s2 += rb[4 * JJ + 2] * Tc[4 * JJ + 2];
        if constexpr (4 * JJ + 3 < I) s3 += rb[4 * JJ + 3] * Tc[4 * JJ + 3];
        if constexpr (I + 1 < 64) { const f32x4 v = *(const LAS f32x4*)(LM + (I + 1) * 64 + 4 * JJ); rb[4 * JJ + 0] = v[0]; rb[4 * JJ + 1] = v[1]; rb[4 * JJ + 2] = v[2]; rb[4 * JJ + 3] = v[3]; }
        __builtin_amdgcn_sched_barrier(0);
        if constexpr (JJ + 1 < 16) sub_group<I, JJ + 1>(Tc, rb, s0, s1, s2, s3, LM);
    }
}
template <int I> __device__ __forceinline__ void sub_row(float (&Tc)[64], float (&rb)[64], const float fl, const LAS float* LM) {
    float s0 = 0.f, s1 = 0.f, s2 = 0.f, s3 = 0.f;
    sub_group<I, 0>(Tc, rb, s0, s1, s2, s3, LM);
    Tc[I] = fmaxf(0.f, 1.f - fabsf(fl - (float)I)) - ((s0 + s1) + (s2 + s3));
    if constexpr (I + 1 < 64) sub_row<I + 1>(Tc, rb, fl, LM);
}
__device__ __forceinline__ void phase_chunk(const Args& a, LAS unsigned char* lds, const int wave_s) {
    TID_SETUP; const int l15 = lane & 15, q = lane >> 4;
    unsigned char* ws = a.ws;
    const bf16_t* proj = (const bf16_t*)(ws + WS_PROJ); const float* AB = (const float*)(ws + WS_AB);
    const float* cwq = a.in[5]; const float* a_log = a.in[6]; const float* dt_bias = a.in[7];
    bf16_t* Ug = (bf16_t*)(ws + WS_U); bf16_t* Wg = (bf16_t*)(ws + WS_W); bf16_t* QDg = (bf16_t*)(ws + WS_QD); bf16_t* KDTg = (bf16_t*)(ws + WS_KDT); bf16_t* QKg = (bf16_t*)(ws + WS_QK);
    float* GL = (float*)(ws + WS_GL);
    float* LMg = (float*)(ws + WS_O);
    bf16_t* RBT = (bf16_t*)(ws + WS_B);
    for (int base = blockIdx.x; base < NCHUNK; base += 8 * gridDim.x) {
        float av_n = 0.f, bv_n = 0.f, al_n = 0.f, dtb_n = 0.f; unsigned xr_n[3][11]; float2 cw_n[3][4];
#define P2_LOAD(chx) do { const int n_ = (chx) & 63, bh_ = (chx) >> 6, h_ = bh_ & 7, b_ = bh_ >> 3; const int s0_ = n_ * 64; const size_t t0_ = (size_t)b_ * SEQ_ + s0_; \
            av_n = AB[(t0_ + lane) * 16 + h_]; bv_n = AB[(t0_ + lane) * 16 + 8 + h_]; al_n = a_log[h_]; dtb_n = dt_bias[h_]; \
            _Pragma("unroll") for (int mat = 0; mat < 3; ++mat) _Pragma("unroll") for (int rr = 0; rr < 11; ++rr) \
                xr_n[mat][rr] = (s0_ + 8 * wave - 3 + rr >= 0) ? *(const unsigned*)(proj + (t0_ + (size_t)(8 * wave + rr) - 3) * NPROJ + 3072 + mat * 1024 + h_ * 128 + 2 * lane) : 0u; \
            _Pragma("unroll") for (int mat = 0; mat < 3; ++mat) _Pragma("unroll") for (int j = 0; j < 4; ++j) cw_n[mat][j] = *(const float2*)(cwq + j * 3072 + mat * 1024 + h_ * 128 + 2 * lane); } while (0)
        P2_LOAD(base);
        for (int kk8 = 0; kk8 < 8; ++kk8) {
            const int ch = base + kk8 * gridDim.x; if (ch >= NCHUNK) break;
            int zv; asm volatile("v_mov_b32 %0, 0" : "=v"(zv));
            LAS unsigned char* ldz = lds + zv;
            LAS bf16_t* QS = (LAS bf16_t*)(ldz); LAS bf16_t* KS = (LAS bf16_t*)(ldz + 17408);
            LAS float* GCs = (LAS float*)(ldz + 34816); LAS float* BETAs = GCs + 64; LAS float* EGs = GCs + 128;
            const int n = ch & 63, bh = ch >> 6, h = bh & 7, b = bh >> 3;
            const int s0 = n * 64; const size_t t0 = (size_t)b * SEQ_ + s0;
            {
                const float av = av_n, bv = bv_n, al = al_n, dtb = dtb_n;
                unsigned xr[3][11]; float2 cwv[3][4];
#pragma unroll
                for (int mat = 0; mat < 3; ++mat) {
#pragma unroll
                    for (int rr = 0; rr < 11; ++rr) xr[mat][rr] = xr_n[mat][rr];
#pragma unroll
                    for (int j = 0; j < 4; ++j) cwv[mat][j] = cw_n[mat][j];
                }
                { const int chn = ch + (int)gridDim.x; if (kk8 + 1 < 8 && chn < NCHUNK) P2_LOAD(chn); }
                const float xg = av + dtb; const float sp = fmaxf(xg, 0.f) + log1pf(__expf(-fabsf(xg)));
                float g = -__expf(al) * sp;
#pragma unroll
                for (int o = 1; o < 64; o <<= 1) { const float tt = __shfl_up(g, o); if (lane >= o) g += tt; }
                const float betal = 1.f / (1.f + __expf(-bv)), egl = __expf(g);
                if (wave == 0) { GCs[lane] = g; BETAs[lane] = betal; EGs[lane] = egl; if (lane == 63) GL[ch] = egl; }
                const float gc63 = __shfl(g, 63);
                float qv[8][2], kv[8][2], vv[8][2];
#pragma unroll
                for (int i = 0; i < 8; ++i) {
                    float a0 = 0.f, a1 = 0.f, b0 = 0.f, b1 = 0.f, c0 = 0.f, c1 = 0.f;
#pragma unroll
                    for (int j = 0; j < 4; ++j) {
                        a0 += cwv[0][j].x * blo(xr[0][i + j]); a1 += cwv[0][j].y * bhi(xr[0][i + j]);
                        b0 += cwv[1][j].x * blo(xr[1][i + j]); b1 += cwv[1][j].y * bhi(xr[1][i + j]);
                        c0 += cwv[2][j].x * blo(xr[2][i + j]); c1 += cwv[2][j].y * bhi(xr[2][i + j]);
                    }
                    a0 = silu_f(a0); a1 = silu_f(a1); b0 = silu_f(b0); b1 = silu_f(b1); c0 = silu_f(c0); c1 = silu_f(c1);
                    const float rq = rsqrtf(wave_sum(a0 * a0 + a1 * a1) + EPS_) * 0.08838834764831845f, rk = rsqrtf(wave_sum(b0 * b0 + b1 * b1) + EPS_);
                    qv[i][0] = a0 * rq; qv[i][1] = a1 * rq; kv[i][0] = b0 * rk; kv[i][1] = b1 * rk; vv[i][0] = c0; vv[i][1] = c1;
                }
                float bet[8], egr[8], kdf[8];
#pragma unroll
                for (int i = 0; i < 8; ++i) { const int r = 8 * wave + i; bet[i] = __shfl(betal, r); egr[i] = __shfl(egl, r); kdf[i] = __expf(gc63 - __shfl(g, r)); }
#pragma unroll
                for (int i = 0; i < 8; ++i) {
                    const int r = 8 * wave + i;
                    *(LAS unsigned*)(QS + r * 136 + 2 * lane) = pk2(qv[i][0], qv[i][1]);
                    *(LAS unsigned*)(KS + r * 136 + 2 * lane) = pk2(kv[i][0], kv[i][1]);
                    *(unsigned*)(QDg + (size_t)ch * 8192 + r * 128 + 2 * lane) = pk2(qv[i][0] * egr[i], qv[i][1] * egr[i]);
                }
#pragma unroll
                for (int cc = 0; cc < 2; ++cc) {
                    u32x4 o;
                    o.x = pk2(vv[0][cc] * bet[0], vv[1][cc] * bet[1]); o.y = pk2(vv[2][cc] * bet[2], vv[3][cc] * bet[3]); o.z = pk2(vv[4][cc] * bet[4], vv[5][cc] * bet[5]); o.w = pk2(vv[6][cc] * bet[6], vv[7][cc] * bet[7]);
                    *(u32x4*)(RBT + (size_t)ch * 16384 + (size_t)(2 * lane + cc) * 64 + 8 * wave) = o;
                    o.x = pk2(kv[0][cc] * bet[0] * egr[0], kv[1][cc] * bet[1] * egr[1]); o.y = pk2(kv[2][cc] * bet[2] * egr[2], kv[3][cc] * bet[3] * egr[3]);
                    o.z = pk2(kv[4][cc] * bet[4] * egr[4], kv[5][cc] * bet[5] * egr[5]); o.w = pk2(kv[6][cc] * bet[6] * egr[6], kv[7][cc] * bet[7] * egr[7]);
                    *(u32x4*)(RBT + (size_t)ch * 16384 + (size_t)(128 + 2 * lane + cc) * 64 + 8 * wave) = o;
                    o.x = pk2(kv[0][cc] * kdf[0], kv[1][cc] * kdf[1]); o.y = pk2(kv[2][cc] * kdf[2], kv[3][cc] * kdf[3]); o.z = pk2(kv[4][cc] * kdf[4], kv[5][cc] * kdf[5]); o.w = pk2(kv[6][cc] * kdf[6], kv[7][cc] * kdf[7]);
                    *(u32x4*)(KDTg + (size_t)ch * 8192 + (size_t)(2 * lane + cc) * 64 + 8 * wave) = o;
                }
            }
            __syncthreads();
            {
                const int ti = wave >> 1;
#pragma unroll
                for (int tjj = 0; tjj < 2; ++tjj) {
                    const int tj = 2 * (wave & 1) + tjj;
                    bf16_t* qkp = QKg + (size_t)ch * 4096;
                    if (tj > ti) {
#pragma unroll
                        for (int j = 0; j < 4; ++j) qkp[(16 * ti + 4 * q + j) * 64 + 16 * tj + l15] = 0;
                        continue;
                    }
                    f32x4 akk = (f32x4){0.f, 0.f, 0.f, 0.f}, aqk = akk;
#pragma unroll
                    for (int ks = 0; ks < 4; ++ks) {
                        const bf16x8 bk = *(const LAS bf16x8*)(KS + (16 * tj + l15) * 136 + 32 * ks + 8 * q);
                        const bf16x8 ak = *(const LAS bf16x8*)(KS + (16 * ti + l15) * 136 + 32 * ks + 8 * q);
                        const bf16x8 aq = *(const LAS bf16x8*)(QS + (16 * ti + l15) * 136 + 32 * ks + 8 * q);
                        akk = __builtin_amdgcn_mfma_f32_16x16x32_bf16(ak, bk, akk, 0, 0, 0);
                        aqk = __builtin_amdgcn_mfma_f32_16x16x32_bf16(aq, bk, aqk, 0, 0, 0);
                    }
                    const int c = 16 * tj + l15; const float gcc = GCs[c];
#pragma unroll
                    for (int j = 0; j < 4; ++j) {
                        const int i = 16 * ti + 4 * q + j;
                        const float dec = (i >= c) ? __expf(GCs[i] - gcc) : 0.f;
                        if (i > c) LMg[(size_t)ch * 4096 + i * 64 + c] = akk[j] * dec * BETAs[i];
                        qkp[i * 64 + c] = f2b((i >= c) ? aqk[j] * dec : 0.f);
                    }
                }
            }
            __syncthreads();
        }
        __syncthreads();
#undef P2_LOAD
        {
            const int ch = base + wave * gridDim.x;
            if (ch < NCHUNK) {
                int zv; asm volatile("v_mov_b32 %0, 0" : "=v"(zv));
                LAS unsigned char* slot = lds + zv + wave * 16384;
                const u32x4* src = (const u32x4*)(LMg + (size_t)ch * 4096) + lane;
                u32x4 cp[16];
#pragma unroll
                for (int it = 0; it < 16; ++it) cp[it] = src[64 * it];
#pragma unroll
                for (int it = 0; it < 16; ++it) *(LAS u32x4*)(slot + (it * 64 + lane) * 16) = cp[it];
                LDS_WAIT();
                const LAS float* LM = (const LAS float*)slot;
                float Tc[64];
                float fl; asm volatile("v_cvt_f32_i32 %0, %1" : "=v"(fl) : "v"(lane));
                float rb[64];
                Tc[0] = fmaxf(0.f, 1.f - fabsf(fl));
                { const f32x4 v = *(const LAS f32x4*)(LM + 64); rb[0] = v[0]; rb[1] = v[1]; rb[2] = v[2]; rb[3] = v[3]; }
                sub_row<1>(Tc, rb, fl, LM);
                LDS_WAIT();
                LAS bf16_t* TM = (LAS bf16_t*)slot;
#pragma unroll
                for (int i = 0; i < 64; ++i) TM[i * 72 + lane] = f2b(Tc[i]);
            }
        }
        __syncthreads();
        for (int kk8 = 0; kk8 < 8; ++kk8) {
            const int ch = base + kk8 * gridDim.x; if (ch >= NCHUNK) break;
            const int ln3 = lane_opaque(), l15 = ln3 & 15, q = ln3 >> 4;
            int zv; asm volatile("v_mov_b32 %0, 0" : "=v"(zv));
            const LAS bf16_t* TM = (const LAS bf16_t*)(lds + zv + kk8 * 16384);
#pragma unroll
            for (int nn = 0; nn < 2; ++nn) {
                const int nt = 2 * wave + nn;
                const bf16_t* XB = RBT + (size_t)ch * 16384 + (size_t)(16 * nt + l15) * 64 + 8 * q;
                const bf16x8 bv0 = *(const bf16x8*)(XB), bv1 = *(const bf16x8*)(XB + 32);
                bf16_t* dst = ((nt < 8) ? Ug : Wg) + (size_t)ch * 8192 + 16 * (nt & 7) + l15;
                const float sgn = (nt < 8) ? 1.f : -1.f;
#pragma unroll
                for (int ti = 0; ti < 4; ++ti) {
                    f32x4 acc = (f32x4){0.f, 0.f, 0.f, 0.f};
                    const bf16x8 av0 = *(const LAS bf16x8*)(TM + (16 * ti + l15) * 72 + 8 * q), av1 = *(const LAS bf16x8*)(TM + (16 * ti + l15) * 72 + 32 + 8 * q);
                    acc = __builtin_amdgcn_mfma_f32_16x16x32_bf16(av0, bv0, acc, 0, 0, 0);
                    acc = __builtin_amdgcn_mfma_f32_16x16x32_bf16(av1, bv1, acc, 0, 0, 0);
#pragma unroll
                    for (int j = 0; j < 4; ++j) dst[(16 * ti + 4 * q + j) * 128] = f2b(acc[j] * sgn);
                }
            }
        }
        __syncthreads();
    }
}

__device__ __forceinline__ bf16x8 ld_a8(const LAS unsigned char* p) {
    const u32x2 lo = *(const LAS u32x2*)p, hi = *(const LAS u32x2*)(p + 32);
    u32x4 v; v.x = lo.x; v.y = lo.y; v.z = hi.x; v.w = hi.y; return __builtin_bit_cast(bf16x8, v);
}
__device__ __forceinline__ bf16x8 pack_frag(const f32x4 a, const f32x4 b) {
    u32x4 v; v.x = pk2(a[0], a[1]); v.y = pk2(a[2], a[3]); v.z = pk2(b[0], b[1]); v.w = pk2(b[2], b[3]); return __builtin_bit_cast(bf16x8, v);
}
__device__ __forceinline__ void phase_scan(const Args& a, LAS unsigned char* lds, const int wave_s) {
    TID_SETUP; const int l15 = lane & 15, q = lane >> 4;
    unsigned char* ws = a.ws;
    const bf16_t* Ug = (const bf16_t*)(ws + WS_U); const bf16_t* Wg = (const bf16_t*)(ws + WS_W); const bf16_t* QDg = (const bf16_t*)(ws + WS_QD);
    const bf16_t* KDTg = (const bf16_t*)(ws + WS_KDT); const bf16_t* QKg = (const bf16_t*)(ws + WS_QK); const float* GL = (const float*)(ws + WS_GL);
    bf16_t* Og = (bf16_t*)(ws + WS_O);
    constexpr int BUF = 66560, WSo = 0, QDo = 17408, KDTo = 34816, QKo = 53248, USo = 62464;
    {
        const int sub_g = gridDim.x > 128 ? (int)gridDim.x - 128 : (int)gridDim.x, sub_c = gridDim.x > 128 ? (int)blockIdx.x - 128 : (int)blockIdx.x;
        if (sub_c >= 0) {
            late_weights(a, lds, wave_s, sub_c, sub_g, 0, gridDim.x > 128 ? LATE_SPLIT : LATE_ITEMS);
            EpiBf16Store Epp; Epp.O = (bf16_t*)a.out; Epp.ldc = D_;
            run_gemm_sub(lds, (const bf16_t*)(ws + WS_PB), (const bf16_t*)(ws + WS_WPP), T_, D_, PLE_, Epp, wave_s, sub_g, sub_c);
            __syncthreads();
        }
    }
    for (int item = blockIdx.x; item < 128; item += gridDim.x) {
        const int bh = item >> 2, sl = item & 3, h = bh & 7, b = bh >> 3;
        LAS unsigned char* XS = lds + 2 * BUF;
        if (wave < 2) {
            const float glv = GL[bh * 64 + lane];
            const int e0 = 16 * wave;
            LAS unsigned char* xsb = XS + wave * 6144; LAS unsigned char* xvb = xsb + 4096;
            f32x4 S[8];
#pragma unroll
            for (int mt = 0; mt < 8; ++mt) S[mt] = (f32x4){0.f, 0.f, 0.f, 0.f};
#pragma unroll
            for (int ks = 0; ks < 4; ++ks) *(LAS u32x4*)(xsb + (ks * 64 + lane) * 16) = (u32x4){0u, 0u, 0u, 0u};
            for (int n = 0; n < 64; ++n) {
                __syncthreads();
                const LAS unsigned char* buf = lds + (n & 1) * BUF;
                const float gl = __shfl(glv, n);
                f32x4 av[4];
                bf16x8 fa[16], fk[16], sb[4], vb[2];
                const LAS bf16_t* Us = (const LAS bf16_t*)(buf + USo);
#pragma unroll
                for (int ks = 0; ks < 4; ++ks)
#pragma unroll
                    for (int it = 0; it < 4; ++it) fa[ks * 4 + it] = ld_a8(buf + WSo + (16 * it + l15) * 272 + (32 * ks + 4 * q) * 2);
#pragma unroll
                for (int it = 0; it < 4; ++it)
#pragma unroll
                    for (int j = 0; j < 4; ++j) av[it][j] = b2f(Us[(16 * it + 4 * q + j) * 32 + e0 + l15]);
#pragma unroll
                for (int mt = 0; mt < 8; ++mt)
#pragma unroll
                    for (int ks = 0; ks < 2; ++ks) fk[mt * 2 + ks] = ld_a8(buf + KDTo + (16 * mt + l15) * 144 + (32 * ks + 4 * q) * 2);
#pragma unroll
                for (int ks = 0; ks < 4; ++ks) sb[ks] = pack_frag(S[2 * ks], S[2 * ks + 1]);
                __builtin_amdgcn_sched_barrier(0);
#pragma unroll
                for (int ks = 0; ks < 4; ++ks)
#pragma unroll
                    for (int it = 0; it < 4; ++it) av[it] = __builtin_amdgcn_mfma_f32_16x16x32_bf16(fa[ks * 4 + it], sb[ks], av[it], 0, 0, 0);
                __builtin_amdgcn_sched_barrier(0);
                vb[0] = pack_frag(av[0], av[1]); vb[1] = pack_frag(av[2], av[3]);
                *(LAS bf16x8*)(xvb + lane * 16) = vb[0]; *(LAS bf16x8*)(xvb + (64 + lane) * 16) = vb[1];
                __syncthreads();
#pragma unroll
                for (int mt = 0; mt < 8; ++mt) {
                    S[mt] = S[mt] * gl;
#pragma unroll
                    for (int ks = 0; ks < 2; ++ks) S[mt] = __builtin_amdgcn_mfma_f32_16x16x32_bf16(fk[mt * 2 + ks], vb[ks], S[mt], 0, 0, 0);
                }
                __builtin_amdgcn_sched_barrier(0);
#pragma unroll
                for (int ks = 0; ks < 4; ++ks) *(LAS bf16x8*)(xsb + (ks * 64 + lane) * 16) = pack_frag(S[2 * ks], S[2 * ks + 1]);
            }
        } else if (wave < 4) {
            const int w2 = wave - 2, e0 = 16 * w2;
            const LAS unsigned char* xsb = XS + w2 * 6144; const LAS unsigned char* xvb = xsb + 4096;
            for (int n = 0; n < 64; ++n) {
                __syncthreads();
                const LAS unsigned char* buf = lds + (n & 1) * BUF;
                f32x4 ao[4];
                bf16x8 fq[16], fc[8], sb[4], vb[2];
#pragma unroll
                for (int ks = 0; ks < 4; ++ks) sb[ks] = *(const LAS bf16x8*)(xsb + (ks * 64 + lane) * 16);
#pragma unroll
                for (int ks = 0; ks < 4; ++ks)
#pragma unroll
                    for (int it = 0; it < 4; ++it) fq[ks * 4 + it] = ld_a8(buf + QDo + (16 * it + l15) * 272 + (32 * ks + 4 * q) * 2);
#pragma unroll
                for (int ks = 0; ks < 2; ++ks)
#pragma unroll
                    for (int it = 0; it < 4; ++it) fc[ks * 4 + it] = ld_a8(buf + QKo + (16 * it + l15) * 144 + (32 * ks + 4 * q) * 2);
#pragma unroll
                for (int it = 0; it < 4; ++it) ao[it] = (f32x4){0.f, 0.f, 0.f, 0.f};
                __builtin_amdgcn_sched_barrier(0);
#pragma unroll
                for (int ks = 0; ks < 4; ++ks)
#pragma unroll
                    for (int it = 0; it < 4; ++it) ao[it] = __builtin_amdgcn_mfma_f32_16x16x32_bf16(fq[ks * 4 + it], sb[ks], ao[it], 0, 0, 0);
                __syncthreads();
                vb[0] = *(const LAS bf16x8*)(xvb + lane * 16); vb[1] = *(const LAS bf16x8*)(xvb + (64 + lane) * 16);
#pragma unroll
                for (int ks = 0; ks < 2; ++ks)
#pragma unroll
                    for (int it = 0; it < 4; ++it) ao[it] = __builtin_amdgcn_mfma_f32_16x16x32_bf16(fc[ks * 4 + it], vb[ks], ao[it], 0, 0, 0);
                bf16_t* op = Og + ((size_t)b * SEQ_ + n * 64) * 1024 + h * 128 + 32 * sl + e0 + l15;
#pragma unroll
                for (int it = 0; it < 4; ++it)
#pragma unroll
                    for (int j = 0; j < 4; ++j) op[(size_t)(16 * it + 4 * q + j) * 1024] = f2b(ao[it][j]);
            }
        } else {
            const int lt = tid - 256;
            u32x4 r0[15], r1[15];
#define SC_GLOAD(R, nn) do { const size_t chh = (size_t)bh * 64 + (nn); \
                const u32x4* pw = (const u32x4*)(Wg + chh * 8192) + lt; const u32x4* pq = (const u32x4*)(QDg + chh * 8192) + lt; const u32x4* pk = (const u32x4*)(KDTg + chh * 8192) + lt; \
                const u32x4* pqk = (const u32x4*)(QKg + chh * 4096) + lt; \
                _Pragma("unroll") for (int _i = 0; _i < 4; ++_i) { R[_i] = pw[256 * _i]; R[4 + _i] = pq[256 * _i]; R[8 + _i] = pk[256 * _i]; } \
                R[12] = pqk[0]; R[13] = pqk[256]; R[14] = *(const u32x4*)(Ug + chh * 8192 + (lt >> 2) * 128 + 32 * sl + 8 * (lt & 3)); } while (0)
#define SC_LSTORE(R, bufp) do { int ltv = lt; asm volatile("" : "+v"(ltv)); \
                LAS unsigned char* _w = (bufp) + WSo + (ltv >> 4) * 272 + (ltv & 15) * 16; LAS unsigned char* _k = (bufp) + KDTo + (ltv >> 3) * 144 + (ltv & 7) * 16; \
                _Pragma("unroll") for (int _i = 0; _i < 4; ++_i) { *(LAS u32x4*)(_w + 4352 * _i) = R[_i]; *(LAS u32x4*)(_w + (QDo - WSo) + 4352 * _i) = R[4 + _i]; *(LAS u32x4*)(_k + 4608 * _i) = R[8 + _i]; } \
                *(LAS u32x4*)(_k + (QKo - KDTo)) = R[12]; *(LAS u32x4*)(_k + (QKo - KDTo) + 4608) = R[13]; *(LAS u32x4*)((bufp) + USo + ltv * 16) = R[14]; } while (0)
            SC_GLOAD(r0, 0);
            SC_LSTORE(r0, lds);
            SC_GLOAD(r0, 1);
            SC_GLOAD(r1, 2);
            for (int n = 0; n < 64; n += 2) {
                __syncthreads();
                SC_LSTORE(r0, lds + BUF);
                SC_GLOAD(r0, (n + 3 < 64 ? n + 3 : 63));
                __syncthreads();
                __syncthreads();
                if (n + 2 < 64) SC_LSTORE(r1, lds);
                SC_GLOAD(r1, (n + 4 < 64 ? n + 4 : 63));
                __syncthreads();
            }
#undef SC_GLOAD
#undef SC_LSTORE
        }
        __syncthreads();
    }
    if (gridDim.x > 128 && blockIdx.x < 128) late_weights(a, lds, wave_s, (int)blockIdx.x, 128, LATE_SPLIT, LATE_ITEMS);
}

__device__ __forceinline__ void phase_mix_out(const Args& a, const int wave_s) {
    TID_SETUP; const int gw = blockIdx.x * 8 + wave, NGW = gridDim.x * 8, gt = blockIdx.x * 512 + tid, NGT = gridDim.x * 512;
    unsigned char* ws = a.ws;
    const bf16_t* proj = (const bf16_t*)(ws + WS_PROJ); const bf16_t* Og = (const bf16_t*)(ws + WS_O); bf16_t* ycat = (bf16_t*)(ws + WS_YCAT);
    const float* dng = a.in[8]; const float* caw = a.in[4];
    {
        const int sub = lane >> 4, c8 = (lane & 15) * 8;
        const f32x4 g0 = *(const f32x4*)(dng + c8), g1 = *(const f32x4*)(dng + c8 + 4);
        constexpr int NIT = T_ * 8 / 4;
        for (int it0 = gw; it0 < NIT; it0 += 4 * NGW) {
            u32x4 ov[4], zv[4];
#pragma unroll
            for (int k = 0; k < 4; ++k) { const int it = it0 + k * NGW; if (it < NIT) { const int pair = it * 4 + sub, t = pair >> 3, h = pair & 7;
                ov[k] = *(const u32x4*)(Og + (size_t)t * 1024 + h * 128 + c8); zv[k] = *(const u32x4*)(proj + (size_t)t * NPROJ + 6144 + h * 128 + c8); } }
#pragma unroll
            for (int k = 0; k < 4; ++k) { const int it = it0 + k * NGW; if (it < NIT) { const int pair = it * 4 + sub, t = pair >> 3, h = pair & 7;
                float o[8] = {blo(ov[k].x), bhi(ov[k].x), blo(ov[k].y), bhi(ov[k].y), blo(ov[k].z), bhi(ov[k].z), blo(ov[k].w), bhi(ov[k].w)};
                const float z[8] = {blo(zv[k].x), bhi(zv[k].x), blo(zv[k].y), bhi(zv[k].y), blo(zv[k].z), bhi(zv[k].z), blo(zv[k].w), bhi(zv[k].w)};
                float ss = 0.f;
#pragma unroll
                for (int e = 0; e < 8; ++e) ss += o[e] * o[e];
                ss += __shfl_xor(ss, 1); ss += __shfl_xor(ss, 2); ss += __shfl_xor(ss, 4); ss += __shfl_xor(ss, 8);
                const float rs = rsqrtf(ss * (1.f / HD) + EPS_);
#pragma unroll
                for (int e = 0; e < 8; ++e) o[e] = o[e] * rs * (e < 4 ? g0[e & 3] : g1[e & 3]) * silu_f(z[e]);
                u32x4 w; w.x = pk2(o[0], o[1]); w.y = pk2(o[2], o[3]); w.z = pk2(o[4], o[5]); w.w = pk2(o[6], o[7]);
                *(u32x4*)(ycat + (size_t)t * D_ + 1024 + h * 128 + c8) = w; } }
        }
    }
    {
        for (int i = gt; i < T_ * 128; i += NGT) {
            const int t = i >> 7, c8 = (i & 127) * 8, s = t & (SEQ_ - 1);
            float accv[8] = {0.f, 0.f, 0.f, 0.f, 0.f, 0.f, 0.f, 0.f};
#pragma unroll
            for (int j = 0; j < 3; ++j) {
                if (s - 2 + j >= 0) {
                    const bf16_t* rp = proj + (size_t)(t - 2 + j) * NPROJ + c8;
                    const u32x4 xv = *(const u32x4*)(rp), cv = *(const u32x4*)(rp + 2048);
                    const f32x4 w0 = *(const f32x4*)(caw + j * 1024 + c8), w1 = *(const f32x4*)(caw + j * 1024 + c8 + 4);
                    accv[0] += w0[0] * blo(xv.x) * blo(cv.x); accv[1] += w0[1] * bhi(xv.x) * bhi(cv.x); accv[2] += w0[2] * blo(xv.y) * blo(cv.y); accv[3] += w0[3] * bhi(xv.y) * bhi(cv.y);
                    accv[4] += w1[0] * blo(xv.z) * blo(cv.z); accv[5] += w1[1] * bhi(xv.z) * bhi(cv.z); accv[6] += w1[2] * blo(xv.w) * blo(cv.w); accv[7] += w1[3] * bhi(xv.w) * bhi(cv.w);
                }
            }
            const u32x4 bv = *(const u32x4*)(proj + (size_t)t * NPROJ + 1024 + c8);
            u32x4 w; w.x = pk2(accv[0] * blo(bv.x), accv[1] * bhi(bv.x)); w.y = pk2(accv[2] * blo(bv.y), accv[3] * bhi(bv.y));
            w.z = pk2(accv[4] * blo(bv.z), accv[5] * bhi(bv.z)); w.w = pk2(accv[6] * blo(bv.w), accv[7] * bhi(bv.w));
            *(u32x4*)(ycat + (size_t)t * D_ + c8) = w;
        }
    }
}

__device__ __forceinline__ void phase_fixup(const Args& a, const int wave_s) {
    TID_SETUP; const int gt = blockIdx.x * 512 + tid, NGT = gridDim.x * 512;
    unsigned char* ws = a.ws; const float* edge = (const float*)(ws + WS_EDGE); bf16_t* act = (bf16_t*)(ws + WS_ACT); const float* cw = a.in[12];
    for (int i = gt; i < 256 * 2 * 1408; i += NGT) {
        const int cq = i % 1408, rr = (i / 1408) & 1, G = i / 2816;
        const int c = 4 * cq, np = (c >> 7) * 256 + (c & 127);
        f32x4 y[2];
#pragma unroll
        for (int gv = 0; gv < 2; ++gv) {
            const int off = gv * 128, wcol = gv * DFF + c;
            f32x4 em2 = (f32x4){0.f, 0.f, 0.f, 0.f}, em1 = em2;
            if ((G & 63) != 0) { em2 = *(const f32x4*)(edge + ((size_t)(G - 1) * 4 + 0) * NUP + np + off); em1 = *(const f32x4*)(edge + ((size_t)(G - 1) * 4 + 1) * NUP + np + off); }
            const f32x4 e0 = *(const f32x4*)(edge + ((size_t)G * 4 + 2) * NUP + np + off), e1 = *(const f32x4*)(edge + ((size_t)G * 4 + 3) * NUP + np + off);
            const f32x4 w0 = *(const f32x4*)(cw + wcol), w1 = *(const f32x4*)(cw + NUP + wcol), w2 = *(const f32x4*)(cw + 2 * NUP + wcol);
            y[gv] = rr == 0 ? (w0 * em2 + w1 * em1 + w2 * e0) : (w0 * em1 + w1 * e0 + w2 * e1);
        }
        u32x2 w; w.x = pk2(silu_f(y[0][0]) * y[1][0], silu_f(y[0][1]) * y[1][1]); w.y = pk2(silu_f(y[0][2]) * y[1][2], silu_f(y[0][3]) * y[1][3]);
        *(u32x2*)(act + (size_t)(64 * G + rr) * DFF + c) = w;
    }
}
__device__ __forceinline__ void phase_final(const Args& a, const int wave_s) {
    TID_SETUP; const int gt = blockIdx.x * 512 + tid, NGT = gridDim.x * 512;
    const float* rss3 = (const float*)(a.ws + WS_RSS) + 2 * T_; const f32x4* g4 = (const f32x4*)a.in[17]; f32x4* o4 = (f32x4*)a.out; const u32x2* x3 = (const u32x2*)(a.ws + WS_X3B);
    constexpr int N4 = T_ * D_ / 4;
    for (int i0 = gt; i0 < N4; i0 += 4 * NGT) {
        u32x2 xw[4]; float ssv[4]; f32x4 gv[4];
#pragma unroll
        for (int k = 0; k < 4; ++k) { const int i = i0 + k * NGT; if (i < N4) { xw[k] = x3[i]; ssv[k] = rss3[i >> 9]; gv[k] = g4[i & 511]; } }
#pragma unroll
        for (int k = 0; k < 4; ++k) { const int i = i0 + k * NGT; if (i < N4) { const float rs = rsqrtf(ssv[k] * (1.f / D_) + EPS_); const f32x4 g = gv[k];
            f32x4 v; v[0] = blo(xw[k].x) * rs * g[0]; v[1] = bhi(xw[k].x) * rs * g[1]; v[2] = blo(xw[k].y) * rs * g[2]; v[3] = bhi(xw[k].y) * rs * g[3]; o4[i] = v; } }
    }
}

__global__ void __launch_bounds__(512) mega(Args a) {
    extern __shared__ __attribute__((aligned(16))) unsigned char lds_raw[];
    LAS unsigned char* lds = (LAS unsigned char*)lds_raw;
    cg::grid_group grid = cg::this_grid();
    const int wave_s = __builtin_amdgcn_readfirstlane((int)(threadIdx.x >> 6));
    unsigned char* ws = a.ws;
    float* rss = (float*)(ws + WS_RSS);
    unsigned* barw = (unsigned*)(ws + WS_BAR);
    volatile LAS unsigned* xst = (volatile LAS unsigned*)(lds + LDS_BYTES - 16);
    if (wave_s == 0) { const int l0 = lane_opaque(); if (l0 < 4) xst[l0] = 0u; }
    __syncthreads();
    if (wave_s == 0 && lane_opaque() == 0) (void)xb_add(&barw[XB_XCNT(xb_xcc_id())], 1u);
    if (a.ph_hi > 1000) grid.sync();
#define GRID_BAR() xcd_barrier(barw, xst, wave_s == 0 && lane_opaque() == 0)
#ifndef DUP_MASK
#define DUP_MASK 0
#endif
#define PH(i, body) if (a.ph_lo <= (i) && (i) < a.ph_hi) { if ((DUP_MASK >> (i)) & 1) { body; GRID_BAR(); } body; if ((i) + 1 < a.ph_hi) GRID_BAR(); }
    PH(0, phase0(a, lds, wave_s));
    PH(1, phase1(a, lds, wave_s));
    PH(2, phase_chunk(a, lds, wave_s));
    PH(3, phase_scan(a, lds, wave_s));
    PH(4, phase_mix_out(a, wave_s));
    PH(5, { EpiResidual<false> E; E.resf = a.in[0]; E.resb = nullptr; E.outb = (bf16_t*)(ws + WS_X1B); E.rss = rss;
            run_gemm(lds, (const bf16_t*)(ws + WS_YCAT), (const bf16_t*)(ws + WS_WOUT), T_, D_, D_, E, wave_s); });
    PH(6, { EpiUp E; E.act = (bf16_t*)(ws + WS_ACT); E.edge = (float*)(ws + WS_EDGE); E.rss = rss; E.cw = a.in[12];
            run_gemm(lds, (const bf16_t*)(ws + WS_X1B), (const bf16_t*)(ws + WS_WUP), T_, NUP, D_, E, wave_s); });
    PH(7, phase_fixup(a, wave_s));
    PH(8, { EpiResidual<true> E; E.resf = nullptr; E.resb = (const bf16_t*)(ws + WS_X1B); E.outb = (bf16_t*)(ws + WS_X1B); E.rss = rss + T_;
            run_gemm(lds, (const bf16_t*)(ws + WS_ACT), (const bf16_t*)(ws + WS_WDOWN), T_, D_, DFF, E, wave_s); });
    PH(9, { EpiPle E; E.x2b = (const bf16_t*)(ws + WS_X1B); E.x3b = (bf16_t*)(ws + WS_X3B); E.pp = (const bf16_t*)a.out; E.rss2 = rss + T_; E.rss3 = rss + 2 * T_;
            run_gemm(lds, (const bf16_t*)(ws + WS_X1B), (const bf16_t*)(ws + WS_WPG), T_, D_, D_, E, wave_s); });
    PH(10, phase_final(a, wave_s));
#undef PH
}

extern "C" void kernel_launch(void* const* d_in, const int* in_sizes, int n_in, void* d_out, int out_size, void* d_ws, size_t ws_size, hipStream_t stream) {
    static int grid = 0;
    if (grid == 0) {
        if (n_in != 18 || in_sizes[0] != T_ * D_ || out_size != T_ * D_ || ws_size < WS_END) { fprintf(stderr, "kernel_launch: unexpected shapes (n_in %d, ws %zu, need %zu)\n", n_in, ws_size, (size_t)WS_END); grid = -1; return; }
        int dev = 0, cus = 0, per_cu = 0;
        if (hipGetDevice(&dev) != hipSuccess || hipDeviceGetAttribute(&cus, hipDeviceAttributeMultiprocessorCount, dev) != hipSuccess) { grid = -1; return; }
        if (hipFuncSetAttribute((const void*)mega, hipFuncAttributeMaxDynamicSharedMemorySize, LDS_BYTES) != hipSuccess) { fprintf(stderr, "kernel_launch: hipFuncSetAttribute failed\n"); grid = -1; return; }
        if (hipOccupancyMaxActiveBlocksPerMultiprocessor(&per_cu, (const void*)mega, 512, LDS_BYTES) != hipSuccess || per_cu < 1) { fprintf(stderr, "kernel_launch: occupancy query says %d blocks per CU\n", per_cu); per_cu = 1; }
        (void)hipGetLastError();
        grid = cus;
    }
    if (grid < 0) return;
    Args a{};
    for (int i = 0; i < 18; ++i) a.in[i] = (const float*)d_in[i];
    a.out = (float*)d_out; a.ws = (unsigned char*)d_ws; a.ph_lo = 0; a.ph_hi = NPHASE;
    if (hipMemsetAsync((char*)d_ws + WS_BAR, 0, (size_t)XCD_BAR_WORDS * 4, stream) != hipSuccess) { fprintf(stderr, "kernel_launch: memset of the barrier words failed\n"); return; }
    void* args[] = {&a};
    hipError_t e = hipLaunchCooperativeKernel((const void*)mega, dim3(grid), dim3(512), args, LDS_BYTES, stream);
    if (e != hipSuccess) fprintf(stderr, "kernel_launch: cooperative launch failed: %s (grid %d)\n", hipGetErrorString(e), grid);
}
```

```cpp
#include <hip/hip_runtime.h>
#include <hip/hip_cooperative_groups.h>
#include <cstdio>
namespace cg = cooperative_groups;

#define LAS __attribute__((address_space(3)))
typedef unsigned short bf16_t;
typedef short bf16x8 __attribute__((ext_vector_type(8)));
typedef float f32x4 __attribute__((ext_vector_type(4)));
typedef unsigned u32x4 __attribute__((ext_vector_type(4)));
typedef unsigned u32x2 __attribute__((ext_vector_type(2)));

constexpr int T_ = 16384, D_ = 2048, SEQ_ = 4096, NPROJ = 7168, INCOLS = 7184, HD = 128, DFF = 5632, NUP = 11264, PLE_ = 256, NCHUNK = 2048;
constexpr float EPS_ = 1e-6f;
constexpr int LDS_BYTES = 147456;
constexpr int NPHASE = 11;

constexpr size_t WS_WIN = 0;
constexpr size_t WS_WAB = WS_WIN + (size_t)NPROJ * D_ * 2;
constexpr size_t WS_WOUT = WS_WAB + 16 * D_ * 2;
constexpr size_t WS_B = WS_WOUT + (size_t)D_ * D_ * 2;
constexpr size_t WS_PROJ = WS_B + (size_t)T_ * D_ * 2;
constexpr size_t WS_ACT = WS_PROJ;
constexpr size_t WS_X3B = WS_PROJ;
constexpr size_t WS_EDGE = WS_ACT + (size_t)T_ * DFF * 2;
constexpr size_t WS_D = WS_PROJ + (size_t)T_ * NPROJ * 2;
constexpr size_t CH16 = (size_t)NCHUNK * 64 * 128 * 2;
constexpr size_t WS_U = WS_D;
constexpr size_t WS_W = WS_U + CH16;
constexpr size_t WS_QD = WS_W + CH16;
constexpr size_t WS_KDT = WS_QD + CH16;
constexpr size_t WS_QK = WS_KDT + CH16;
constexpr size_t WS_O = WS_QK + (size_t)NCHUNK * 64 * 64 * 2;
constexpr size_t WS_DEND = WS_O + (size_t)T_ * 1024 * 2;
constexpr size_t WS_YCAT = WS_D;
constexpr size_t WS_PP = WS_D;
constexpr size_t WS_X1B = WS_D + (size_t)T_ * D_ * 2;
constexpr size_t WS_WUP = WS_B;
constexpr size_t WS_WPG = WS_WUP + (size_t)NUP * D_ * 2;
constexpr size_t WS_LATE_END = WS_WPG + (size_t)D_ * D_ * 2;
constexpr size_t WS_WDOWN = WS_WIN;
static_assert(WS_LATE_END <= WS_PROJ, "late weights overflow region B");
static_assert((size_t)D_ * DFF * 2 <= (size_t)NPROJ * D_ * 2, "w_down copy overflow");
static_assert(WS_X1B + (size_t)T_ * D_ * 2 <= WS_O, "x1b overlaps O");
static_assert(WS_EDGE + (size_t)256 * 4 * NUP * 4 <= WS_D, "edge overflow");
constexpr size_t WS_AB = WS_DEND;
constexpr size_t WS_RSS = WS_AB + (size_t)T_ * 16 * 4;
constexpr size_t WS_PB = WS_RSS + (size_t)3 * T_ * 4;
constexpr size_t WS_GL = WS_PB + (size_t)T_ * PLE_ * 2;
constexpr size_t WS_BAR = WS_GL + NCHUNK * 4;
constexpr int XCD_BAR_WORDS = 3456;
constexpr size_t WS_WPP = (WS_BAR + (size_t)XCD_BAR_WORDS * 4 + 255) / 256 * 256;
constexpr size_t WS_END = WS_WPP + (size_t)D_ * PLE_ * 2;
static_assert(WS_END <= (size_t)512 * 1024 * 1024, "workspace exceeds 512 MiB");

struct Args { const float* in[18]; float* out; unsigned char* ws; int ph_lo, ph_hi; };

typedef __bf16 bf16x2_t __attribute__((ext_vector_type(2)));
typedef float f32x2_t __attribute__((ext_vector_type(2)));
__device__ __forceinline__ unsigned pk2(float lo, float hi) { f32x2_t v = {lo, hi}; bf16x2_t b = __builtin_convertvector(v, bf16x2_t); return __builtin_bit_cast(unsigned, b); }
__device__ __forceinline__ bf16_t f2b(float x) { return (bf16_t)(pk2(x, 0.f) & 0xffffu); }
__device__ __forceinline__ float b2f(bf16_t v) { return __uint_as_float((unsigned)v << 16); }
__device__ __forceinline__ float blo(unsigned v) { return __uint_as_float(v << 16); }
__device__ __forceinline__ float bhi(unsigned v) { return __uint_as_float(v & 0xffff0000u); }
__device__ __forceinline__ float silu_f(float x) { return x * __builtin_amdgcn_rcpf(1.f + __expf(-x)); }
__device__ __forceinline__ float sigmoid_f(float x) { return __builtin_amdgcn_rcpf(1.f + __expf(-x)); }
template <int CTRL> __device__ __forceinline__ float dpp_rot(float v) { return __int_as_float(__builtin_amdgcn_mov_dpp(__float_as_int(v), CTRL, 0xF, 0xF, true)); }
template <int CTRL, int ROWMASK> __device__ __forceinline__ float dpp_f(float v) { return __int_as_float(__builtin_amdgcn_update_dpp(0, __float_as_int(v), CTRL, ROWMASK, 0xF, false)); }
__device__ __forceinline__ float wave_sum(float v) {
    v += dpp_rot<0xB1>(v); v += dpp_rot<0x4E>(v); v += dpp_rot<0x141>(v); v += dpp_rot<0x140>(v);
    v += dpp_f<0x142, 0xA>(v); v += dpp_f<0x143, 0xC>(v);
    return __int_as_float(__builtin_amdgcn_readlane(__float_as_int(v), 63));
}
__device__ __forceinline__ int lane_opaque() { int l; asm volatile("v_mbcnt_lo_u32_b32 %0, -1, 0\n\tv_mbcnt_hi_u32_b32 %0, -1, %0" : "=v"(l)); return l; }
#define TID_SETUP const int lane = lane_opaque(); const int tid = wave_s * 64 + lane; const int wave = wave_s; (void)wave; (void)lane
__device__ __forceinline__ float bperm(float v, int byteaddr) { return __int_as_float(__builtin_amdgcn_ds_bpermute(byteaddr, __float_as_int(v))); }
#define LDS_WAIT() asm volatile("s_waitcnt lgkmcnt(0)" ::: "memory")


#define XB_TMO      128
#define XB_XCNT(j)  (256  + 64 * (j))
#define XB_XSUB(j)  (1280 + 64 * (j))
#define XB_XGEN(j)  (2304 + 64 * (j))
#define XB_TOP      3328
#define XB_TOPGEN   3392
#define XB_SPIN_CAP (1u << 22)
__device__ __forceinline__ unsigned xb_ld(unsigned* p)              { return __hip_atomic_load(p, __ATOMIC_RELAXED, __HIP_MEMORY_SCOPE_AGENT); }
__device__ __forceinline__ unsigned xb_add(unsigned* p, unsigned v) { return __hip_atomic_fetch_add(p, v, __ATOMIC_RELAXED, __HIP_MEMORY_SCOPE_AGENT); }
__device__ __forceinline__ unsigned xb_xcc_id() { return (unsigned)__builtin_amdgcn_s_getreg((3 << 11) | 20) & 0xFu; }
#define XB_SPIN(cond, bar) do { unsigned _sp = 0; while (cond) { __builtin_amdgcn_s_sleep(1); \
    if ((++_sp & 255u) == 0u) { if (xb_ld(&(bar)[XB_TMO])) break; if (_sp > XB_SPIN_CAP) { atomicAdd(&(bar)[XB_TMO], 1u); break; } } } } while (0)
__device__ __forceinline__ void xcd_barrier_complete(unsigned* bar, unsigned x, unsigned& nloc, unsigned& nx) {
    const unsigned G = gridDim.x;
    unsigned sum, cnt, mine, sp = 0u;
    for (;;) {
        sum = 0u; cnt = 0u; mine = 0u;
#pragma unroll
        for (unsigned j = 0; j < 16; ++j) { const unsigned c = xb_ld(&bar[XB_XCNT(j)]); sum += c; cnt += (c > 0u) ? 1u : 0u; mine = (j == x) ? c : mine; }
        if (sum == G) break;
        __builtin_amdgcn_s_sleep(1);
        if ((++sp & 255u) == 0u) { if (xb_ld(&bar[XB_TMO])) break; if (sp > XB_SPIN_CAP) { atomicAdd(&bar[XB_TMO], 1u); break; } }
    }
    nloc = mine > 0u ? mine : 1u; nx = cnt > 0u ? cnt : 1u;
}
__device__ __forceinline__ void xcd_barrier(unsigned* bar, volatile LAS unsigned* st, const bool leader) {
    asm volatile("s_waitcnt vmcnt(0)" ::: "memory");
    __syncthreads();
    if (leader) {
        const unsigned x = xb_xcc_id();
        __builtin_amdgcn_s_waitcnt(0);
        unsigned nloc = st[0], nx = st[1];
        if (nloc == 0u) { xcd_barrier_complete(bar, x, nloc, nx); st[0] = nloc; st[1] = nx; }
        const unsigned old = xb_add(&bar[XB_XSUB(x)], 1u);
        const unsigned gen = old / nloc;
        if (old + 1u == (gen + 1u) * nloc) {
            __builtin_amdgcn_fence(__ATOMIC_RELEASE, "agent");
            asm volatile("s_waitcnt vmcnt(0)" ::: "memory");
            const unsigned og = xb_add(&bar[XB_TOP], 1u);
            const unsigned tg = og / nx;
            if (og + 1u == (tg + 1u) * nx) xb_add(&bar[XB_TOPGEN], 1u);
            else XB_SPIN(xb_ld(&bar[XB_TOPGEN]) == tg, bar);
            __builtin_amdgcn_fence(__ATOMIC_ACQUIRE, "agent");
            xb_add(&bar[XB_XGEN(x)], 1u);
            asm volatile("s_waitcnt vmcnt(0)" ::: "memory");
        } else {
            XB_SPIN(xb_ld(&bar[XB_XGEN(x)]) == gen, bar);
            __builtin_amdgcn_fence(__ATOMIC_ACQUIRE, "agent");
            asm volatile("s_waitcnt vmcnt(0)" ::: "memory");
        }
    }
    __syncthreads();
}

namespace pg8 {
constexpr int BM = 256, BK = 64, HALF = 128, HTB = HALF * BK * 2, STAGE_BYTES = 8 * HTB, NXCD = 8, WGM = 8;
__host__ __device__ __forceinline__ int lds_byte(int r, int c) { const int st = (r >> 4) * 2 + (c >> 5), rr = r & 15, cc = c & 31, ob = rr * 64 + cc * 2; return st * 1024 + (ob ^ (((ob >> 9) & 1) << 5)); }
__host__ __device__ __forceinline__ void stage_rc(int b, int& R, int& C) { const int st = b / 1024, sb = b % 1024, swz = sb ^ (((sb >> 9) & 1) << 5); R = (st >> 1) * 16 + swz / 64; C = (st & 1) * 32 + (swz % 64) / 2; }
__host__ __device__ __forceinline__ int perm32(int rho) { const int n = rho >> 4, i = rho & 15; return 8 * (i >> 2) + 4 * n + (i & 3); }
struct Unit { int pm, pn; };
struct Gemm { const bf16_t* A; const bf16_t* Bt; int M, N, K; };
struct StaticOrder {
    int nM, nN, nwg, G, c;
    __host__ __device__ void init(int M, int N, int G_, int c_) { nM = M / BM; nN = N / BM; nwg = nM * nN; G = G_; c = c_; }
    __host__ __device__ bool next(int i, Unit& u) const {
        const long L = (long)i * G + c; if (L >= nwg) return false;
        int wgid = (int)L; { const int q = nwg / NXCD, r = nwg % NXCD, xcd = wgid % NXCD, off = wgid / NXCD; wgid = (xcd < r ? xcd * (q + 1) : r * (q + 1) + (xcd - r) * q) + off; }
        const int nig = WGM * nN, gid = wgid / nig, fm = gid * WGM, gsz = (nM - fm) < WGM ? (nM - fm) : WGM;
        u.pm = fm + ((wgid % nig) % gsz); u.pn = (wgid % nig) / gsz; return true;
    }
};
template <class Epi>
__device__ __forceinline__ void gemm_phase(LAS unsigned char* lds, const Gemm g, const StaticOrder& S, const Epi& E, const int wave_s) {
    const int lane = lane_opaque(), tid = wave_s * 64 + lane, wid = wave_s, wr = wid >> 2, wc = wid & 3, fr = lane & 15, fq = lane >> 4;
    const int K = g.K, nt = K / BK;
    unsigned voffA[2], voffB[2];
#pragma unroll
    for (int i = 0; i < 2; ++i) { int R, C; stage_rc(tid * 16 + i * 8192, R, C); const int Rb = Epi::PERM ? ((R & ~31) + perm32(R & 31)) : R;
        const int Ra = Epi::PERM_A ? ((R & ~63) + 4 * (R & 15) + ((R >> 4) & 3)) : R;
        voffA[i] = (unsigned)(Ra * K + C) * 2u; voffB[i] = (unsigned)(Rb * K + C) * 2u; }
    const size_t kstep = (size_t)(BK * 2);
    const size_t hstep = (size_t)HALF * K * 2;
    const size_t tstep = 2 * hstep;
    const unsigned ldsw = (unsigned)wid * 1024u;
    const int aoff = lds_byte(wr * 64 + fr, fq * 8), boff = lds_byte(wc * 32 + fr, fq * 8);
#define PG8_SA(b, h) (((b) * 2 + (h)) * HTB)
#define PG8_SB(b, h) ((4 + (b) * 2 + (h)) * HTB)
#define PG8_STAGE(bufoff, gbase, voff) do { _Pragma("unroll") for (int _i = 0; _i < 2; ++_i) \
        __builtin_amdgcn_global_load_lds((const unsigned*)((const char*)(gbase) + (voff)[_i]), (LAS unsigned*)(lds + (bufoff) + ldsw + _i * 8192), 16, 0, 0); } while (0)
#define PG8_LDA(dst, b, h) do { _Pragma("unroll") for (int m = 0; m < 4; ++m) _Pragma("unroll") for (int k = 0; k < 2; ++k) dst[m][k] = *(const LAS bf16x8*)(lds + PG8_SA(b, h) + aoff + m * 2048 + k * 1024); } while (0)
#define PG8_LDB(dst, b, h) do { _Pragma("unroll") for (int n = 0; n < 2; ++n) _Pragma("unroll") for (int k = 0; k < 2; ++k) dst[n][k] = *(const LAS bf16x8*)(lds + PG8_SB(b, h) + boff + n * 2048 + k * 1024); } while (0)
#define PG8_MMA(ai, bj, At, Bt) do { __builtin_amdgcn_s_setprio(1); _Pragma("unroll") for (int m = 0; m < 4; ++m) _Pragma("unroll") for (int n = 0; n < 2; ++n) _Pragma("unroll") for (int k = 0; k < 2; ++k) \
        acc[ai][bj][m][n] = __builtin_amdgcn_mfma_f32_16x16x32_bf16(Bt[n][k], At[m][k], acc[ai][bj][m][n], 0, 0, 0); __builtin_amdgcn_s_setprio(0); } while (0)
#define PG8_WAIT_V(n) asm volatile("s_waitcnt vmcnt(" #n ")" ::: "memory")
#define PG8_WAIT_L(n) asm volatile("s_waitcnt lgkmcnt(" #n ")" ::: "memory")
#define PG8_BAR __builtin_amdgcn_s_barrier()
#define PG8_SCHED __builtin_amdgcn_sched_barrier(0)
    Unit cur, nxt; int ui = 0;
    if (!S.next(0, cur)) return;
    f32x4 acc[2][2][4][2];
#pragma unroll
    for (int a = 0; a < 2; ++a)
#pragma unroll
        for (int b = 0; b < 2; ++b)
#pragma unroll
            for (int m = 0; m < 4; ++m)
#pragma unroll
                for (int n = 0; n < 2; ++n) acc[a][b][m][n] = (f32x4){0.f, 0.f, 0.f, 0.f};
    bf16x8 At[4][2], B0[2][2], B1[2][2];
    const char* cA = (const char*)g.A + (size_t)cur.pm * tstep; const char* cB = (const char*)g.Bt + (size_t)cur.pn * tstep;
    PG8_STAGE(PG8_SB(0, 0), cB, voffB); PG8_STAGE(PG8_SA(0, 0), cA, voffA); PG8_STAGE(PG8_SB(0, 1), cB + hstep, voffB); PG8_STAGE(PG8_SA(0, 1), cA + hstep, voffA);
    if (wr == 1) PG8_BAR;
    PG8_WAIT_V(4); PG8_BAR;
    PG8_STAGE(PG8_SB(1, 0), cB + kstep, voffB); PG8_STAGE(PG8_SA(1, 0), cA + kstep, voffA); PG8_STAGE(PG8_SB(1, 1), cB + hstep + kstep, voffB);
    PG8_WAIT_V(6); PG8_BAR;
    for (;;) {
        const bool has_next = S.next(ui + 1, nxt);
        const char* nA = has_next ? (const char*)g.A + (size_t)nxt.pm * tstep : cA; const char* nB = has_next ? (const char*)g.Bt + (size_t)nxt.pn * tstep : cB;
        for (int t = 0; t < nt; t += 2) {
            const bool last = (t == nt - 2);
            const char* a1 = cA + (size_t)(t + 1) * kstep;
            const char* a2 = last ? nA : cA + (size_t)(t + 2) * kstep; const char* b2 = last ? nB : cB + (size_t)(t + 2) * kstep;
            const char* a3 = a2 + kstep; const char* b3 = b2 + kstep;
            PG8_LDB(B0, 0, 0); PG8_SCHED; PG8_LDA(At, 0, 0); PG8_STAGE(PG8_SA(1, 1), a1 + hstep, voffA);
            PG8_WAIT_L(8); PG8_BAR; PG8_WAIT_L(0); PG8_MMA(0, 0, At, B0); PG8_BAR; PG8_SCHED;
            PG8_LDB(B1, 0, 1); PG8_STAGE(PG8_SB(0, 0), b2, voffB);
            PG8_BAR; PG8_WAIT_L(0); PG8_MMA(0, 1, At, B1); PG8_BAR;
            PG8_LDA(At, 0, 1); PG8_STAGE(PG8_SA(0, 0), a2, voffA);
            PG8_BAR; PG8_WAIT_L(0); PG8_MMA(1, 0, At, B0); PG8_BAR; PG8_SCHED;
            PG8_STAGE(PG8_SB(0, 1), b2 + hstep, voffB);
            PG8_WAIT_V(6); PG8_BAR; PG8_MMA(1, 1, At, B1); PG8_BAR;
            PG8_LDB(B0, 1, 0); PG8_SCHED; PG8_LDA(At, 1, 0); PG8_STAGE(PG8_SA(0, 1), a2 + hstep, voffA);
            PG8_WAIT_L(8); PG8_BAR; PG8_WAIT_L(0); PG8_MMA(0, 0, At, B0); PG8_BAR; PG8_SCHED;
            PG8_LDB(B1, 1, 1); PG8_STAGE(PG8_SB(1, 0), b3, voffB);
            PG8_BAR; PG8_WAIT_L(0); PG8_MMA(0, 1, At, B1); PG8_BAR;
            PG8_LDA(At, 1, 1); PG8_STAGE(PG8_SA(1, 0), a3, voffA);
            PG8_BAR; PG8_WAIT_L(0); PG8_MMA(1, 0, At, B0); PG8_BAR; PG8_SCHED;
            PG8_STAGE(PG8_SB(1, 1), b3 + hstep, voffB);
            PG8_WAIT_V(6); PG8_BAR; PG8_MMA(1, 1, At, B1); PG8_BAR;
        }
        E(acc, cur, wr, wc, fr, fq);
        if (!has_next) break;
#pragma unroll
        for (int a = 0; a < 2; ++a)
#pragma unroll
            for (int b = 0; b < 2; ++b)
#pragma unroll
                for (int m = 0; m < 4; ++m)
#pragma unroll
                    for (int n = 0; n < 2; ++n) acc[a][b][m][n] = (f32x4){0.f, 0.f, 0.f, 0.f};
        cur = nxt; cA = nA; cB = nB; ++ui;
    }
    PG8_WAIT_V(0);
    if (wr == 0) PG8_BAR;
    PG8_BAR;
#undef PG8_SA
#undef PG8_SB
#undef PG8_STAGE
#undef PG8_LDA
#undef PG8_LDB
#undef PG8_MMA
#undef PG8_WAIT_V
#undef PG8_WAIT_L
#undef PG8_BAR
#undef PG8_SCHED
}
}
using pg8::Unit;
typedef const f32x4 (&AccRef)[2][2][4][2];

struct EpiBf16Store {
    static constexpr bool PERM = true, PERM_A = false;
    bf16_t* O; int ldc;
    __device__ __forceinline__ void operator()(AccRef acc, const Unit& u, int wr, int wc, int fr, int fq) const {
        { const int l_ = lane_opaque(); fr = l_ & 15; fq = l_ >> 4; }
        const int row0 = u.pm * 256 + wr * 64 + fr, col0 = u.pn * 256 + wc * 32 + 8 * fq;
#pragma unroll
        for (int ai = 0; ai < 2; ++ai)
#pragma unroll
            for (int m = 0; m < 4; ++m) { bf16_t* rowp = O + (size_t)(row0 + ai * 128 + m * 16) * ldc + col0;
#pragma unroll
                for (int bj = 0; bj < 2; ++bj) { const f32x4 v0 = acc[ai][bj][m][0], v1 = acc[ai][bj][m][1];
                    u32x4 w; w.x = pk2(v0[0], v0[1]); w.y = pk2(v0[2], v0[3]); w.z = pk2(v1[0], v1[1]); w.w = pk2(v1[2], v1[3]); *(u32x4*)(rowp + bj * 128) = w; } }
    }
};
template <bool RES_BF16> struct EpiResidual {
    static constexpr bool PERM = true, PERM_A = false;
    const float* resf; const bf16_t* resb; bf16_t* outb; float* rss;
    __device__ __forceinline__ void operator()(AccRef acc, const Unit& u, int wr, int wc, int fr, int fq) const {
        { const int l_ = lane_opaque(); fr = l_ & 15; fq = l_ >> 4; }
        const int row0 = u.pm * 256 + wr * 64 + fr, col0 = u.pn * 256 + wc * 32 + 8 * fq;
#pragma unroll
        for (int ai = 0; ai < 2; ++ai) {
            u32x4 rb[4][2]; f32x4 rf[4][2][2];
#pragma unroll
            for (int m = 0; m < 4; ++m)
#pragma unroll
                for (int bj = 0; bj < 2; ++bj) { const size_t o = (size_t)(row0 + ai * 128 + m * 16) * D_ + col0 + bj * 128;
                    if (RES_BF16) rb[m][bj] = *(const u32x4*)(resb + o); else { rf[m][bj][0] = *(const f32x4*)(resf + o); rf[m][bj][1] = *(const f32x4*)(resf + o + 4); } }
            __builtin_amdgcn_sched_barrier(0);
#pragma unroll
            for (int m = 0; m < 4; ++m) { const int row = row0 + ai * 128 + m * 16; const size_t ro = (size_t)row * D_ + col0; float ss = 0.f;
#pragma unroll
                for (int bj = 0; bj < 2; ++bj) { const size_t o = ro + bj * 128; f32x4 r0, r1;
                    if (RES_BF16) { const u32x4 rw = rb[m][bj]; r0[0] = blo(rw.x); r0[1] = bhi(rw.x); r0[2] = blo(rw.y); r0[3] = bhi(rw.y); r1[0] = blo(rw.z); r1[1] = bhi(rw.z); r1[2] = blo(rw.w); r1[3] = bhi(rw.w); }
                    else { r0 = rf[m][bj][0]; r1 = rf[m][bj][1]; }
                    const f32x4 v0 = acc[ai][bj][m][0] + r0, v1 = acc[ai][bj][m][1] + r1;
                    u32x4 w; w.x = pk2(v0[0], v0[1]); w.y = pk2(v0[2], v0[3]); w.z = pk2(v1[0], v1[1]); w.w = pk2(v1[2], v1[3]); *(u32x4*)(outb + o) = w;
                    ss += v0[0] * v0[0] + v0[1] * v0[1] + v0[2] * v0[2] + v0[3] * v0[3] + v1[0] * v1[0] + v1[1] * v1[1] + v1[2] * v1[2] + v1[3] * v1[3]; }
                ss += __shfl_xor(ss, 16); ss += __shfl_xor(ss, 32);
                if (fq == 0) atomicAdd(rss + row, ss); }
        }
    }
};
__device__ __forceinline__ f32x4 silu4(const f32x4 x) {
    const f32x4 t = x * (-1.4426950408889634f); f32x4 e; e[0] = __builtin_amdgcn_exp2f(t[0]); e[1] = __builtin_amdgcn_exp2f(t[1]); e[2] = __builtin_amdgcn_exp2f(t[2]); e[3] = __builtin_amdgcn_exp2f(t[3]);
    const f32x4 d = e + 1.0f; f32x4 rc; rc[0] = __builtin_amdgcn_rcpf(d[0]); rc[1] = __builtin_amdgcn_rcpf(d[1]); rc[2] = __builtin_amdgcn_rcpf(d[2]); rc[3] = __builtin_amdgcn_rcpf(d[3]);
    return x * rc;
}
__device__ __forceinline__ f32x4 ror1_4(const f32x4 v) { f32x4 r; r[0] = dpp_rot<0x121>(v[0]); r[1] = dpp_rot<0x121>(v[1]); r[2] = dpp_rot<0x121>(v[2]); r[3] = dpp_rot<0x121>(v[3]); return r; }
struct EpiUp {
    static constexpr bool PERM = false, PERM_A = true;
    bf16_t* act; float* edge; const float* rss; const float* cw;
    __device__ __forceinline__ void operator()(AccRef acc, const Unit& u, int wr, int wc, int fr, int fq) const {
        { const int l_ = lane_opaque(); fr = l_ & 15; fq = l_ >> 4; }
#pragma unroll
        for (int ai = 0; ai < 2; ++ai) {
            const int rowg = u.pm * 256 + ai * 128 + wr * 64;
            const int row0 = rowg + 4 * fr;
            float rs[4];
#pragma unroll
            for (int m = 0; m < 4; ++m) rs[m] = rsqrtf(rss[row0 + m] * (1.f / D_) + EPS_);
            float* eg = edge + (size_t)(rowg >> 6) * 4 * NUP;
#pragma unroll
            for (int n = 0; n < 2; ++n) {
                const int cin = wc * 32 + n * 16 + 4 * fq;
                const int colg = u.pn * 128 + cin;
                const int np = u.pn * 256 + cin;
                f32x4 sg[4];
                {
                    const f32x4 w0 = *(const f32x4*)(cw + colg), w1 = *(const f32x4*)(cw + NUP + colg), w2 = *(const f32x4*)(cw + 2 * NUP + colg);
                    const f32x4 g0 = acc[ai][0][0][n] * rs[0], g1 = acc[ai][0][1][n] * rs[1], g2 = acc[ai][0][2][n] * rs[2], g3 = acc[ai][0][3][n] * rs[3];
                    const f32x4 p3 = ror1_4(g3), p2 = ror1_4(g2);
                    sg[0] = silu4(w0 * p2 + w1 * p3 + w2 * g0);
                    sg[1] = silu4(w0 * p3 + w1 * g0 + w2 * g1);
                    sg[2] = silu4(w0 * g0 + w1 * g1 + w2 * g2);
                    sg[3] = silu4(w0 * g1 + w1 * g2 + w2 * g3);
                    if (fr == 0) { *(f32x4*)(eg + 2 * NUP + np) = g0; *(f32x4*)(eg + 3 * NUP + np) = g1; }
                    if (fr == 15) { *(f32x4*)(eg + np) = g2; *(f32x4*)(eg + NUP + np) = g3; }
                    __builtin_amdgcn_sched_barrier(0);
                }
                {
                    const f32x4 w0 = *(const f32x4*)(cw + DFF + colg), w1 = *(const f32x4*)(cw + NUP + DFF + colg), w2 = *(const f32x4*)(cw + 2 * NUP + DFF + colg);
                    const f32x4 v0 = acc[ai][1][0][n] * rs[0], v1 = acc[ai][1][1][n] * rs[1], v2 = acc[ai][1][2][n] * rs[2], v3 = acc[ai][1][3][n] * rs[3];
                    const f32x4 p3 = ror1_4(v3), p2 = ror1_4(v2);
                    f32x4 r[4];
                    r[0] = sg[0] * (w0 * p2 + w1 * p3 + w2 * v0);
                    r[1] = sg[1] * (w0 * p3 + w1 * v0 + w2 * v1);
                    r[2] = sg[2] * (w0 * v0 + w1 * v1 + w2 * v2);
                    r[3] = sg[3] * (w0 * v1 + w1 * v2 + w2 * v3);
#pragma unroll
                    for (int m = 0; m < 4; ++m)
                        if (!(m < 2 && fr == 0)) { u32x2 w; w.x = pk2(r[m][0], r[m][1]); w.y = pk2(r[m][2], r[m][3]); *(u32x2*)(act + (size_t)(row0 + m) * DFF + colg) = w; }
                    if (fr == 0) { *(f32x4*)(eg + 2 * NUP + np + 128) = v0; *(f32x4*)(eg + 3 * NUP + np + 128) = v1; }
                    if (fr == 15) { *(f32x4*)(eg + np + 128) = v2; *(f32x4*)(eg + NUP + np + 128) = v3; }
                    __builtin_amdgcn_sched_barrier(0);
                }
            }
        }
    }
};
struct EpiPle {
    static constexpr bool PERM = true, PERM_A = false;
    const bf16_t* x2b; bf16_t* x3b; const bf16_t* pp; const float* rss2; float* rss3;
    __device__ __forceinline__ void operator()(AccRef acc, const Unit& u, int wr, int wc, int fr, int fq) const {
        { const int l_ = lane_opaque(); fr = l_ & 15; fq = l_ >> 4; }
        const int row0 = u.pm * 256 + wr * 64 + fr, col0 = u.pn * 256 + wc * 32 + 8 * fq;
#pragma unroll
        for (int ai = 0; ai < 2; ++ai) {
            u32x4 xb[4][2], pb[4][2]; float rsv[4];
#pragma unroll
            for (int m = 0; m < 4; ++m) { rsv[m] = rss2[row0 + ai * 128 + m * 16];
#pragma unroll
                for (int bj = 0; bj < 2; ++bj) { const size_t o = (size_t)(row0 + ai * 128 + m * 16) * D_ + col0 + bj * 128; xb[m][bj] = *(const u32x4*)(x2b + o); pb[m][bj] = *(const u32x4*)(pp + o); } }
            __builtin_amdgcn_sched_barrier(0);
#pragma unroll
            for (int m = 0; m < 4; ++m) { const int row = row0 + ai * 128 + m * 16; const size_t ro = (size_t)row * D_ + col0; float ss = 0.f;
                const float rs = rsqrtf(rsv[m] * (1.f / D_) + EPS_);
#pragma unroll
                for (int bj = 0; bj < 2; ++bj) { const size_t o = ro + bj * 128; const f32x4 a0 = acc[ai][bj][m][0] * rs, a1 = acc[ai][bj][m][1] * rs;
                    const u32x4 xw = xb[m][bj], pw = pb[m][bj];
                    f32x4 v0, v1;
                    v0[0] = blo(xw.x) + sigmoid_f(a0[0]) * blo(pw.x); v0[1] = bhi(xw.x) + sigmoid_f(a0[1]) * bhi(pw.x); v0[2] = blo(xw.y) + sigmoid_f(a0[2]) * blo(pw.y); v0[3] = bhi(xw.y) + sigmoid_f(a0[3]) * bhi(pw.y);
                    v1[0] = blo(xw.z) + sigmoid_f(a1[0]) * blo(pw.z); v1[1] = bhi(xw.z) + sigmoid_f(a1[1]) * bhi(pw.z); v1[2] = blo(xw.w) + sigmoid_f(a1[2]) * blo(pw.w); v1[3] = bhi(xw.w) + sigmoid_f(a1[3]) * bhi(pw.w);
                    u32x4 w; w.x = pk2(v0[0], v0[1]); w.y = pk2(v0[2], v0[3]); w.z = pk2(v1[0], v1[1]); w.w = pk2(v1[2], v1[3]); *(u32x4*)(x3b + o) = w;
                    ss += v0[0] * v0[0] + v0[1] * v0[1] + v0[2] * v0[2] + v0[3] * v0[3] + v1[0] * v1[0] + v1[1] * v1[1] + v1[2] * v1[2] + v1[3] * v1[3]; }
                ss += __shfl_xor(ss, 16); ss += __shfl_xor(ss, 32);
                if (fq == 0) atomicAdd(rss3 + row, ss); }
        }
    }
};
template <class Epi> __device__ __forceinline__ void run_gemm_sub(LAS unsigned char* lds, const bf16_t* A, const bf16_t* Bt, int M, int N, int K, const Epi& E, const int wave_s, const int G, const int c) {
    pg8::Gemm g; g.A = A; g.Bt = Bt; g.M = M; g.N = N; g.K = K; pg8::StaticOrder S; S.init(M, N, G, c); pg8::gemm_phase(lds, g, S, E, wave_s);
}
template <class Epi> __device__ __forceinline__ void run_gemm(LAS unsigned char* lds, const bf16_t* A, const bf16_t* Bt, int M, int N, int K, const Epi& E, const int wave_s) {
    pg8::Gemm g; g.A = A; g.Bt = Bt; g.M = M; g.N = N; g.K = K; pg8::StaticOrder S; S.init(M, N, (int)gridDim.x, (int)blockIdx.x); pg8::gemm_phase(lds, g, S, E, wave_s);
}

struct TItem { const float* W; int K, N, k0, n0; bf16_t* WT; int drow0; const float* gk; };
__device__ __forceinline__ void transpose_load(const TItem& t, float (&tv)[32], int lane) {
#pragma unroll
    for (int i = 0; i < 32; ++i) tv[i] = __builtin_nontemporal_load(&t.W[(size_t)(t.k0 + 2 * i + (lane >> 5)) * t.N + t.n0 + (lane & 31)]);
}
__device__ __forceinline__ void transpose_store(const TItem& t, const float (&tv)[32], LAS float* scr, int lane) {
#pragma unroll
    for (int i = 0; i < 32; ++i) { const int kk = 2 * i + (lane >> 5); float v = tv[i]; if (t.gk) v *= t.gk[t.k0 + kk]; scr[kk * 33 + (lane & 31)] = v; }
    LDS_WAIT();
    const int c = lane & 7;
#pragma unroll
    for (int j = 0; j < 4; ++j) { const int n = (lane >> 3) + 8 * j; const LAS float* s = scr + (8 * c) * 33 + n;
        u32x4 o; o.x = pk2(s[0 * 33], s[1 * 33]); o.y = pk2(s[2 * 33], s[3 * 33]); o.z = pk2(s[4 * 33], s[5 * 33]); o.w = pk2(s[6 * 33], s[7 * 33]);
        *(u32x4*)(t.WT + (size_t)(t.drow0 + n) * t.K + t.k0 + 8 * c) = o; }
    LDS_WAIT();
}
__device__ __forceinline__ TItem early_item(const Args& a, unsigned char* ws, int it) {
    constexpr int I_IN = 32 * 224, I_OUT = 32 * 64; TItem t; t.gk = nullptr;
    if (it < I_IN) { const int kb = it / 224, nb = it % 224; t.W = a.in[3]; t.K = D_; t.N = INCOLS; t.k0 = 64 * kb; t.n0 = 32 * nb; t.WT = (bf16_t*)(ws + WS_WIN); t.drow0 = 32 * nb; }
    else if (it < I_IN + I_OUT) { const int r = it - I_IN, kb = r / 64, nb = r % 64; t.W = a.in[9]; t.K = D_; t.N = D_; t.k0 = 64 * kb; t.n0 = 32 * nb; t.WT = (bf16_t*)(ws + WS_WOUT); t.drow0 = 32 * nb; }
    else { const int r = it - I_IN - I_OUT, kb = r / 64, nb = r % 64; t.W = a.in[16]; t.K = PLE_; t.N = D_; t.k0 = 64 * kb; t.n0 = 32 * nb; t.WT = (bf16_t*)(ws + WS_WPP); t.drow0 = 32 * nb; }
    return t;
}
__device__ __forceinline__ TItem late_item(const Args& a, unsigned char* ws, int it) {
    constexpr int I_UP = 32 * 352, I_DN = 88 * 64; TItem t;
    if (it < I_UP) { const int kb = it / 352, nb = it % 352, n0 = 32 * nb; t.W = a.in[11]; t.K = D_; t.N = NUP; t.k0 = 64 * kb; t.n0 = n0; t.WT = (bf16_t*)(ws + WS_WUP);
        t.drow0 = n0 < DFF ? (n0 / 128) * 256 + (n0 % 128) : ((n0 - DFF) / 128) * 256 + 128 + ((n0 - DFF) % 128); t.gk = a.in[10]; }
    else if (it < I_UP + I_DN) { const int r = it - I_UP, kb = r / 64, nb = r % 64; t.W = a.in[13]; t.K = DFF; t.N = D_; t.k0 = 64 * kb; t.n0 = 32 * nb; t.WT = (bf16_t*)(ws + WS_WDOWN); t.drow0 = 32 * nb; t.gk = nullptr; }
    else { const int r = it - I_UP - I_DN, kb = r / 64, nb = r % 64; t.W = a.in[15]; t.K = D_; t.N = D_; t.k0 = 64 * kb; t.n0 = 32 * nb; t.WT = (bf16_t*)(ws + WS_WPG); t.drow0 = 32 * nb; t.gk = a.in[14]; }
    return t;
}
template <bool LATE> __device__ __forceinline__ void transpose_items(const Args& a, unsigned char* ws, LAS float* scr, int lane, int first, int step, int total) {
    if (first >= total) return;
    TItem cur = LATE ? late_item(a, ws, first) : early_item(a, ws, first);
    float tv[32]; transpose_load(cur, tv, lane);
    for (int it = first; it < total; it += step) {
        const int nit = it + step; TItem nx = cur; float tn[32];
        if (nit < total) { nx = LATE ? late_item(a, ws, nit) : early_item(a, ws, nit); transpose_load(nx, tn, lane); }
        else {
#pragma unroll
            for (int i = 0; i < 32; ++i) tn[i] = 0.f; }
        transpose_store(cur, tv, scr, lane);
        cur = nx;
#pragma unroll
        for (int i = 0; i < 32; ++i) tv[i] = tn[i];
    }
}

__device__ __forceinline__ void phase0(const Args& a, LAS unsigned char* lds, const int wave_s) {
    TID_SETUP;
    const int gw = blockIdx.x * 8 + wave, NGW = gridDim.x * 8, gt = blockIdx.x * 512 + tid, NGT = gridDim.x * 512;
    unsigned char* ws = a.ws;
    float* rss = (float*)(ws + WS_RSS);
    for (int i = gt; i < 3 * T_; i += NGT) rss[i] = 0.f;
    { float* ab0 = (float*)(ws + WS_AB); for (int i = gt; i < T_ * 16; i += NGT) ab0[i] = 0.f; }
    { bf16_t* wab = (bf16_t*)(ws + WS_WAB); const float* w_in = a.in[3];
      for (int i = gt; i < 16 * D_; i += NGT) { const int n = i >> 11, k = i & 2047; wab[i] = f2b(w_in[(size_t)k * INCOLS + NPROJ + n]); } }
    { const f32x4* p4 = (const f32x4*)a.in[1]; u32x2* pb = (u32x2*)(ws + WS_PB);
      for (int i = gt; i < T_ * PLE_ / 4; i += NGT) { const f32x4 v = __builtin_nontemporal_load(&p4[i]); u32x2 o; o.x = pk2(v[0], v[1]); o.y = pk2(v[2], v[3]); pb[i] = o; } }
    { const float* x = a.in[0]; const f32x4* g4 = (const f32x4*)a.in[2]; bf16_t* hb = (bf16_t*)(ws + WS_B);
      for (int row = gw; row < T_; row += NGW) {
          const f32x4* xr = (const f32x4*)(x + (size_t)row * D_) + lane; f32x4 v[8]; float s = 0.f;
#pragma unroll
          for (int j = 0; j < 8; ++j) { v[j] = __builtin_nontemporal_load(&xr[64 * j]); s += v[j][0] * v[j][0] + v[j][1] * v[j][1] + v[j][2] * v[j][2] + v[j][3] * v[j][3]; }
          const float rstd = rsqrtf(wave_sum(s) * (1.f / D_) + EPS_);
          u32x2* o8 = (u32x2*)(hb + (size_t)row * D_) + lane;
#pragma unroll
          for (int j = 0; j < 8; ++j) { const f32x4 g = g4[lane + 64 * j]; u32x2 o; o.x = pk2(v[j][0] * rstd * g[0], v[j][1] * rstd * g[1]); o.y = pk2(v[j][2] * rstd * g[2], v[j][3] * rstd * g[3]); o8[64 * j] = o; }
      } }
    { LAS float* scr = (LAS float*)(lds + wave * 8448);
      transpose_items<false>(a, ws, scr, lane, gw, NGW, 32 * 224 + 32 * 64 + 4 * 64); }
}
__device__ __forceinline__ void late_weights(const Args& a, LAS unsigned char* lds, const int wave_s, const int blk, const int nblk) {
    TID_SETUP; (void)tid; const int gw = blk * 8 + wave, NGW = nblk * 8;
    unsigned char* ws = a.ws; LAS float* scr = (LAS float*)(lds + wave * 8448);
    transpose_items<true>(a, ws, scr, lane, gw, NGW, 32 * 352 + 88 * 64 + 32 * 64);
    __syncthreads();
}

__device__ __forceinline__ void phase1(const Args& a, LAS unsigned char* lds, const int wave_s) {
    TID_SETUP; (void)tid; const int gw = blockIdx.x * 8 + wave, NGW = gridDim.x * 8;
    unsigned char* ws = a.ws; const bf16_t* hb = (const bf16_t*)(ws + WS_B);
    { const bf16_t* wab = (const bf16_t*)(ws + WS_WAB); float* AB = (float*)(ws + WS_AB); const int l15 = lane & 15, q = lane >> 4;
      for (int it2 = gw; it2 < 2 * (T_ / 16); it2 += NGW) {
          const int tt = it2 >> 1, kh = it2 & 1;
          f32x4 acc = (f32x4){0.f, 0.f, 0.f, 0.f};
          const bf16_t* ap = hb + (size_t)(16 * tt + l15) * D_ + 1024 * kh + 8 * q; const bf16_t* bp = wab + (size_t)l15 * D_ + 1024 * kh + 8 * q;
#pragma unroll 16
          for (int ks = 0; ks < 32; ++ks) { const bf16x8 av = *(const bf16x8*)(ap + 32 * ks), bv = *(const bf16x8*)(bp + 32 * ks); acc = __builtin_amdgcn_mfma_f32_16x16x32_bf16(av, bv, acc, 0, 0, 0); }
#pragma unroll
          for (int j = 0; j < 4; ++j) atomicAdd(AB + (size_t)(16 * tt + 4 * q + j) * 16 + l15, acc[j]);
      } }
    EpiBf16Store E; E.O = (bf16_t*)(ws + WS_PROJ); E.ldc = NPROJ;
    run_gemm(lds, hb, (const bf16_t*)(ws + WS_WIN), T_, NPROJ, D_, E, wave_s);
}

template <int I, int JJ> __device__ __forceinline__ void sub_group(float (&Tc)[64], float (&rb)[64], float& s0, float& s1, float& s2, float& s3, const LAS float* LM) {
    if constexpr (4 * JJ < I + 1) {
        if constexpr (4 * JJ + 0 < I) s0 += rb[4 * JJ + 0] * Tc[4 * JJ + 0];
        if constexpr (4 * JJ + 1 < I) s1 += rb[4 * JJ + 1] * Tc[4 * JJ + 1];
        if constexpr (4 * JJ + 2 < I) s2 += rb[4 * JJ + 2] * Tc[4 * JJ + 2];
        if constexpr (4 * JJ + 3 < I) s3 += rb[4 * JJ + 3] * Tc[4 * JJ + 3];
        if constexpr (I + 1 < 64) { const f32x4 v = *(const LAS f32x4*)(LM + (I + 1) * 64 + 4 * JJ); rb[4 * JJ + 0] = v[0]; rb[4 * JJ + 1] = v[1]; rb[4 * JJ + 2] = v[2]; rb[4 * JJ + 3] = v[3]; }
        __builtin_amdgcn_sched_barrier(0);
        if constexpr (JJ + 1 < 16) sub_group<I, JJ + 1>(Tc, rb, s0, s1, s2, s3, LM);
    }
}
template <int I> __device__ __forceinline__ void sub_row(float (&Tc)[64], float (&rb)[64], const float fl, const LAS float* LM) {
    float s0 = 0.f, s1 = 0.f, s2 = 0.f, s3 = 0.f;
    sub_group<I, 0>(Tc, rb, s0, s1, s2, s3, LM);
    Tc[I] = fmaxf(0.f, 1.f - fabsf(fl - (float)I)) - ((s0 + s1) + (s2 + s3));
    if constexpr (I + 1 < 64) sub_row<I + 1>(Tc, rb, fl, LM);
}
__device__ __forceinline__ void phase_chunk(const Args& a, LAS unsigned char* lds, const int wave_s) {
    TID_SETUP; const int l15 = lane & 15, q = lane >> 4;
    unsigned char* ws = a.ws;
    const bf16_t* proj = (const bf16_t*)(ws + WS_PROJ); const float* AB = (const float*)(ws + WS_AB);
    const float* cwq = a.in[5]; const float* a_log = a.in[6]; const float* dt_bias = a.in[7];
    bf16_t* Ug = (bf16_t*)(ws + WS_U); bf16_t* Wg = (bf16_t*)(ws + WS_W); bf16_t* QDg = (bf16_t*)(ws + WS_QD); bf16_t* KDTg = (bf16_t*)(ws + WS_KDT); bf16_t* QKg = (bf16_t*)(ws + WS_QK);
    float* GL = (float*)(ws + WS_GL);
    float* LMg = (float*)(ws + WS_O);
    bf16_t* RBT = (bf16_t*)(ws + WS_B);
    for (int base = blockIdx.x; base < NCHUNK; base += 8 * gridDim.x) {
        float av_n = 0.f, bv_n = 0.f, al_n = 0.f, dtb_n = 0.f; unsigned xr_n[3][11]; float2 cw_n[3][4];
#define P2_LOAD(chx) do { const int n_ = (chx) & 63, bh_ = (chx) >> 6, h_ = bh_ & 7, b_ = bh_ >> 3; const int s0_ = n_ * 64; const size_t t0_ = (size_t)b_ * SEQ_ + s0_; \
            av_n = AB[(t0_ + lane) * 16 + h_]; bv_n = AB[(t0_ + lane) * 16 + 8 + h_]; al_n = a_log[h_]; dtb_n = dt_bias[h_]; \
            _Pragma("unroll") for (int mat = 0; mat < 3; ++mat) _Pragma("unroll") for (int rr = 0; rr < 11; ++rr) \
                xr_n[mat][rr] = (s0_ + 8 * wave - 3 + rr >= 0) ? *(const unsigned*)(proj + (t0_ + (size_t)(8 * wave + rr) - 3) * NPROJ + 3072 + mat * 1024 + h_ * 128 + 2 * lane) : 0u; \
            _Pragma("unroll") for (int mat = 0; mat < 3; ++mat) _Pragma("unroll") for (int j = 0; j < 4; ++j) cw_n[mat][j] = *(const float2*)(cwq + j * 3072 + mat * 1024 + h_ * 128 + 2 * lane); } while (0)
        P2_LOAD(base);
        for (int kk8 = 0; kk8 < 8; ++kk8) {
            const int ch = base + kk8 * gridDim.x; if (ch >= NCHUNK) break;
            int zv; asm volatile("v_mov_b32 %0, 0" : "=v"(zv));
            LAS unsigned char* ldz = lds + zv;
            LAS bf16_t* QS = (LAS bf16_t*)(ldz); LAS bf16_t* KS = (LAS bf16_t*)(ldz + 17408);
            LAS float* GCs = (LAS float*)(ldz + 34816); LAS float* BETAs = GCs + 64; LAS float* EGs = GCs + 128;
            const int n = ch & 63, bh = ch >> 6, h = bh & 7, b = bh >> 3;
            const int s0 = n * 64; const size_t t0 = (size_t)b * SEQ_ + s0;
            {
                const float av = av_n, bv = bv_n, al = al_n, dtb = dtb_n;
                unsigned xr[3][11]; float2 cwv[3][4];
#pragma unroll
                for (int mat = 0; mat < 3; ++mat) {
#pragma unroll
                    for (int rr = 0; rr < 11; ++rr) xr[mat][rr] = xr_n[mat][rr];
#pragma unroll
                    for (int j = 0; j < 4; ++j) cwv[mat][j] = cw_n[mat][j];
                }
                { const int chn = ch + (int)gridDim.x; if (kk8 + 1 < 8 && chn < NCHUNK) P2_LOAD(chn); }
                const float xg = av + dtb; const float sp = fmaxf(xg, 0.f) + log1pf(__expf(-fabsf(xg)));
                float g = -__expf(al) * sp;
#pragma unroll
                for (int o = 1; o < 64; o <<= 1) { const float tt = __shfl_up(g, o); if (lane >= o) g += tt; }
                const float betal = 1.f / (1.f + __expf(-bv)), egl = __expf(g);
                if (wave == 0) { GCs[lane] = g; BETAs[lane] = betal; EGs[lane] = egl; if (lane == 63) GL[ch] = egl; }
                const float gc63 = __shfl(g, 63);
                float qv[8][2], kv[8][2], vv[8][2];
#pragma unroll
                for (int i = 0; i < 8; ++i) {
                    float a0 = 0.f, a1 = 0.f, b0 = 0.f, b1 = 0.f, c0 = 0.f, c1 = 0.f;
#pragma unroll
                    for (int j = 0; j < 4; ++j) {
                        a0 += cwv[0][j].x * blo(xr[0][i + j]); a1 += cwv[0][j].y * bhi(xr[0][i + j]);
                        b0 += cwv[1][j].x * blo(xr[1][i + j]); b1 += cwv[1][j].y * bhi(xr[1][i + j]);
                        c0 += cwv[2][j].x * blo(xr[2][i + j]); c1 += cwv[2][j].y * bhi(xr[2][i + j]);
                    }
                    a0 = silu_f(a0); a1 = silu_f(a1); b0 = silu_f(b0); b1 = silu_f(b1); c0 = silu_f(c0); c1 = silu_f(c1);
                    const float rq = rsqrtf(wave_sum(a0 * a0 + a1 * a1) + EPS_) * 0.08838834764831845f, rk = rsqrtf(wave_sum(b0 * b0 + b1 * b1) + EPS_);
                    qv[i][0] = a0 * rq; qv[i][1] = a1 * rq; kv[i][0] = b0 * rk; kv[i][1] = b1 * rk; vv[i][0] = c0; vv[i][1] = c1;
                }
                float bet[8], egr[8], kdf[8];
#pragma unroll
                for (int i = 0; i < 8; ++i) { const int r = 8 * wave + i; bet[i] = __shfl(betal, r); egr[i] = __shfl(egl, r); kdf[i] = __expf(gc63 - __shfl(g, r)); }
#pragma unroll
                for (int i = 0; i < 8; ++i) {
                    const int r = 8 * wave + i;
                    *(LAS unsigned*)(QS + r * 136 + 2 * lane) = pk2(qv[i][0], qv[i][1]);
                    *(LAS unsigned*)(KS + r * 136 + 2 * lane) = pk2(kv[i][0], kv[i][1]);
                    *(unsigned*)(QDg + (size_t)ch * 8192 + r * 128 + 2 * lane) = pk2(qv[i][0] * egr[i], qv[i][1] * egr[i]);
                }
#pragma unroll
                for (int cc = 0; cc < 2; ++cc) {
                    u32x4 o;
                    o.x = pk2(vv[0][cc] * bet[0], vv[1][cc] * bet[1]); o.y = pk2(vv[2][cc] * bet[2], vv[3][cc] * bet[3]); o.z = pk2(vv[4][cc] * bet[4], vv[5][cc] * bet[5]); o.w = pk2(vv[6][cc] * bet[6], vv[7][cc] * bet[7]);
                    *(u32x4*)(RBT + (size_t)ch * 16384 + (size_t)(2 * lane + cc) * 64 + 8 * wave) = o;
                    o.x = pk2(kv[0][cc] * bet[0] * egr[0], kv[1][cc] * bet[1] * egr[1]); o.y = pk2(kv[2][cc] * bet[2] * egr[2], kv[3][cc] * bet[3] * egr[3]);
                    o.z = pk2(kv[4][cc] * bet[4] * egr[4], kv[5][cc] * bet[5] * egr[5]); o.w = pk2(kv[6][cc] * bet[6] * egr[6], kv[7][cc] * bet[7] * egr[7]);
                    *(u32x4*)(RBT + (size_t)ch * 16384 + (size_t)(128 + 2 * lane + cc) * 64 + 8 * wave) = o;
                    o.x = pk2(kv[0][cc] * kdf[0], kv[1][cc] * kdf[1]); o.y = pk2(kv[2][cc] * kdf[2], kv[3][cc] * kdf[3]); o.z = pk2(kv[4][cc] * kdf[4], kv[5][cc] * kdf[5]); o.w = pk2(kv[6][cc] * kdf[6], kv[7][cc] * kdf[7]);
                    *(u32x4*)(KDTg + (size_t)ch * 8192 + (size_t)(2 * lane + cc) * 64 + 8 * wave) = o;
                }
            }
            __syncthreads();
            {
                const int ti = wave >> 1;
#pragma unroll
                for (int tjj = 0; tjj < 2; ++tjj) {
                    const int tj = 2 * (wave & 1) + tjj;
                    bf16_t* qkp = QKg + (size_t)ch * 4096;
                    if (tj > ti) {
#pragma unroll
                        for (int j = 0; j < 4; ++j) qkp[(16 * ti + 4 * q + j) * 64 + 16 * tj + l15] = 0;
                        continue;
                    }
                    f32x4 akk = (f32x4){0.f, 0.f, 0.f, 0.f}, aqk = akk;
#pragma unroll
                    for (int ks = 0; ks < 4; ++ks) {
                        const bf16x8 bk = *(const LAS bf16x8*)(KS + (16 * tj + l15) * 136 + 32 * ks + 8 * q);
                        const bf16x8 ak = *(const LAS bf16x8*)(KS + (16 * ti + l15) * 136 + 32 * ks + 8 * q);
                        const bf16x8 aq = *(const LAS bf16x8*)(QS + (16 * ti + l15) * 136 + 32 * ks + 8 * q);
                        akk = __builtin_amdgcn_mfma_f32_16x16x32_bf16(ak, bk, akk, 0, 0, 0);
                        aqk = __builtin_amdgcn_mfma_f32_16x16x32_bf16(aq, bk, aqk, 0, 0, 0);
                    }
                    const int c = 16 * tj + l15; const float gcc = GCs[c];
#pragma unroll
                    for (int j = 0; j < 4; ++j) {
                        const int i = 16 * ti + 4 * q + j;
                        const float dec = (i >= c) ? __expf(GCs[i] - gcc) : 0.f;
                        if (i > c) LMg[(size_t)ch * 4096 + i * 64 + c] = akk[j] * dec * BETAs[i];
                        qkp[i * 64 + c] = f2b((i >= c) ? aqk[j] * dec : 0.f);
                    }
                }
            }
            __syncthreads();
        }
        __syncthreads();
#undef P2_LOAD
        {
            const int ch = base + wave * gridDim.x;
            if (ch < NCHUNK) {
                int zv; asm volatile("v_mov_b32 %0, 0" : "=v"(zv));
                LAS unsigned char* slot = lds + zv + wave * 16384;
                const u32x4* src = (const u32x4*)(LMg + (size_t)ch * 4096) + lane;
                u32x4 cp[16];
#pragma unroll
                for (int it = 0; it < 16; ++it) cp[it] = src[64 * it];
#pragma unroll
                for (int it = 0; it < 16; ++it) *(LAS u32x4*)(slot + (it * 64 + lane) * 16) = cp[it];
                LDS_WAIT();
                const LAS float* LM = (const LAS float*)slot;
                float Tc[64];
                float fl; asm volatile("v_cvt_f32_i32 %0, %1" : "=v"(fl) : "v"(lane));
                float rb[64];
                Tc[0] = fmaxf(0.f, 1.f - fabsf(fl));
                { const f32x4 v = *(const LAS f32x4*)(LM + 64); rb[0] = v[0]; rb[1] = v[1]; rb[2] = v[2]; rb[3] = v[3]; }
                sub_row<1>(Tc, rb, fl, LM);
                LDS_WAIT();
                LAS bf16_t* TM = (LAS bf16_t*)slot;
#pragma unroll
                for (int i = 0; i < 64; ++i) TM[i * 72 + lane] = f2b(Tc[i]);
            }
        }
        __syncthreads();
        for (int kk8 = 0; kk8 < 8; ++kk8) {
            const int ch = base + kk8 * gridDim.x; if (ch >= NCHUNK) break;
            const int ln3 = lane_opaque(), l15 = ln3 & 15, q = ln3 >> 4;
            int zv; asm volatile("v_mov_b32 %0, 0" : "=v"(zv));
            const LAS bf16_t* TM = (const LAS bf16_t*)(lds + zv + kk8 * 16384);
#pragma unroll
            for (int nn = 0; nn < 2; ++nn) {
                const int nt = 2 * wave + nn;
                const bf16_t* XB = RBT + (size_t)ch * 16384 + (size_t)(16 * nt + l15) * 64 + 8 * q;
                const bf16x8 bv0 = *(const bf16x8*)(XB), bv1 = *(const bf16x8*)(XB + 32);
                bf16_t* dst = ((nt < 8) ? Ug : Wg) + (size_t)ch * 8192 + 16 * (nt & 7) + l15;
                const float sgn = (nt < 8) ? 1.f : -1.f;
#pragma unroll
                for (int ti = 0; ti < 4; ++ti) {
                    f32x4 acc = (f32x4){0.f, 0.f, 0.f, 0.f};
                    const bf16x8 av0 = *(const LAS bf16x8*)(TM + (16 * ti + l15) * 72 + 8 * q), av1 = *(const LAS bf16x8*)(TM + (16 * ti + l15) * 72 + 32 + 8 * q);
                    acc = __builtin_amdgcn_mfma_f32_16x16x32_bf16(av0, bv0, acc, 0, 0, 0);
                    acc = __builtin_amdgcn_mfma_f32_16x16x32_bf16(av1, bv1, acc, 0, 0, 0);
#pragma unroll
                    for (int j = 0; j < 4; ++j) dst[(16 * ti + 4 * q + j) * 128] = f2b(acc[j] * sgn);
                }
            }
        }
        __syncthreads();
    }
}

__device__ __forceinline__ bf16x8 ld_a8(const LAS unsigned char* p) {
    const u32x2 lo = *(const LAS u32x2*)p, hi = *(const LAS u32x2*)(p + 32);
    u32x4 v; v.x = lo.x; v.y = lo.y; v.z = hi.x; v.w = hi.y; return __builtin_bit_cast(bf16x8, v);
}
__device__ __forceinline__ bf16x8 pack_frag(const f32x4 a, const f32x4 b) {
    u32x4 v; v.x = pk2(a[0], a[1]); v.y = pk2(a[2], a[3]); v.z = pk2(b[0], b[1]); v.w = pk2(b[2], b[3]); return __builtin_bit_cast(bf16x8, v);
}
__device__ __forceinline__ void phase_scan(const Args& a, LAS unsigned char* lds, const int wave_s) {
    TID_SETUP; const int l15 = lane & 15, q = lane >> 4;
    unsigned char* ws = a.ws;
    const bf16_t* Ug = (const bf16_t*)(ws + WS_U); const bf16_t* Wg = (const bf16_t*)(ws + WS_W); const bf16_t* QDg = (const bf16_t*)(ws + WS_QD);
    const bf16_t* KDTg = (const bf16_t*)(ws + WS_KDT); const bf16_t* QKg = (const bf16_t*)(ws + WS_QK); const float* GL = (const float*)(ws + WS_GL);
    bf16_t* Og = (bf16_t*)(ws + WS_O);
    constexpr int BUF = 66560, WSo = 0, QDo = 17408, KDTo = 34816, QKo = 53248, USo = 62464;
    {
        const int sub_g = gridDim.x > 128 ? (int)gridDim.x - 128 : (int)gridDim.x, sub_c = gridDim.x > 128 ? (int)blockIdx.x - 128 : (int)blockIdx.x;
        if (sub_c >= 0) {
            late_weights(a, lds, wave_s, sub_c, sub_g);
            EpiBf16Store Epp; Epp.O = (bf16_t*)a.out; Epp.ldc = D_;
            run_gemm_sub(lds, (const bf16_t*)(ws + WS_PB), (const bf16_t*)(ws + WS_WPP), T_, D_, PLE_, Epp, wave_s, sub_g, sub_c);
            __syncthreads();
        }
    }
    for (int item = blockIdx.x; item < 128; item += gridDim.x) {
        const int bh = item >> 2, sl = item & 3, h = bh & 7, b = bh >> 3;
        LAS unsigned char* XS = lds + 2 * BUF;
        if (wave < 2) {
            const float glv = GL[bh * 64 + lane];
            const int e0 = 16 * wave;
            LAS unsigned char* xsb = XS + wave * 6144; LAS unsigned char* xvb = xsb + 4096;
            f32x4 S[8];
#pragma unroll
            for (int mt = 0; mt < 8; ++mt) S[mt] = (f32x4){0.f, 0.f, 0.f, 0.f};
#pragma unroll
            for (int ks = 0; ks < 4; ++ks) *(LAS u32x4*)(xsb + (ks * 64 + lane) * 16) = (u32x4){0u, 0u, 0u, 0u};
            for (int n = 0; n < 64; ++n) {
                __syncthreads();
                const LAS unsigned char* buf = lds + (n & 1) * BUF;
                const float gl = __shfl(glv, n);
                f32x4 av[4];
                bf16x8 fa[16], fk[16], sb[4], vb[2];
                const LAS bf16_t* Us = (const LAS bf16_t*)(buf + USo);
#pragma unroll
                for (int ks = 0; ks < 4; ++ks)
#pragma unroll
                    for (int it = 0; it < 4; ++it) fa[ks * 4 + it] = ld_a8(buf + WSo + (16 * it + l15) * 272 + (32 * ks + 4 * q) * 2);
#pragma unroll
                for (int it = 0; it < 4; ++it)
#pragma unroll
                    for (int j = 0; j < 4; ++j) av[it][j] = b2f(Us[(16 * it + 4 * q + j) * 32 + e0 + l15]);
#pragma unroll
                for (int mt = 0; mt < 8; ++mt)
#pragma unroll
                    for (int ks = 0; ks < 2; ++ks) fk[mt * 2 + ks] = ld_a8(buf + KDTo + (16 * mt + l15) * 144 + (32 * ks + 4 * q) * 2);
#pragma unroll
                for (int ks = 0; ks < 4; ++ks) sb[ks] = pack_frag(S[2 * ks], S[2 * ks + 1]);
                __builtin_amdgcn_sched_barrier(0);
#pragma unroll
                for (int ks = 0; ks < 4; ++ks)
#pragma unroll
                    for (int it = 0; it < 4; ++it) av[it] = __builtin_amdgcn_mfma_f32_16x16x32_bf16(fa[ks * 4 + it], sb[ks], av[it], 0, 0, 0);
                __builtin_amdgcn_sched_barrier(0);
                vb[0] = pack_frag(av[0], av[1]); vb[1] = pack_frag(av[2], av[3]);
                *(LAS bf16x8*)(xvb + lane * 16) = vb[0]; *(LAS bf16x8*)(xvb + (64 + lane) * 16) = vb[1];
                __syncthreads();
#pragma unroll
                for (int mt = 0; mt < 8; ++mt) {
                    S[mt] = S[mt] * gl;
#pragma unroll
                    for (int ks = 0; ks < 2; ++ks) S[mt] = __builtin_amdgcn_mfma_f32_16x16x32_bf16(fk[mt * 2 + ks], vb[ks], S[mt], 0, 0, 0);
                }
                __builtin_amdgcn_sched_barrier(0);
#pragma unroll
                for (int ks = 0; ks < 4; ++ks) *(LAS bf16x8*)(xsb + (ks * 64 + lane) * 16) = pack_frag(S[2 * ks], S[2 * ks + 1]);
            }
        } else if (wave < 4) {
            const int w2 = wave - 2, e0 = 16 * w2;
            const LAS unsigned char* xsb = XS + w2 * 6144; const LAS unsigned char* xvb = xsb + 4096;
            for (int n = 0; n < 64; ++n) {
                __syncthreads();
                const LAS unsigned char* buf = lds + (n & 1) * BUF;
                f32x4 ao[4];
                bf16x8 fq[16], fc[8], sb[4], vb[2];
#pragma unroll
                for (int ks = 0; ks < 4; ++ks) sb[ks] = *(const LAS bf16x8*)(xsb + (ks * 64 + lane) * 16);
#pragma unroll
                for (int ks = 0; ks < 4; ++ks)
#pragma unroll
                    for (int it = 0; it < 4; ++it) fq[ks * 4 + it] = ld_a8(buf + QDo + (16 * it + l15) * 272 + (32 * ks + 4 * q) * 2);
#pragma unroll
                for (int ks = 0; ks < 2; ++ks)
#pragma unroll
                    for (int it = 0; it < 4; ++it) fc[ks * 4 + it] = ld_a8(buf + QKo + (16 * it + l15) * 144 + (32 * ks + 4 * q) * 2);
#pragma unroll
                for (int it = 0; it < 4; ++it) ao[it] = (f32x4){0.f, 0.f, 0.f, 0.f};
                __builtin_amdgcn_sched_barrier(0);
#pragma unroll
                for (int ks = 0; ks < 4; ++ks)
#pragma unroll
                    for (int it = 0; it < 4; ++it) ao[it] = __builtin_amdgcn_mfma_f32_16x16x32_bf16(fq[ks * 4 + it], sb[ks], ao[it], 0, 0, 0);
                __syncthreads();
                vb[0] = *(const LAS bf16x8*)(xvb + lane * 16); vb[1] = *(const LAS bf16x8*)(xvb + (64 + lane) * 16);
#pragma unroll
                for (int ks = 0; ks < 2; ++ks)
#pragma unroll
                    for (int it = 0; it < 4; ++it) ao[it] = __builtin_amdgcn_mfma_f32_16x16x32_bf16(fc[ks * 4 + it], vb[ks], ao[it], 0, 0, 0);
                bf16_t* op = Og + ((size_t)b * SEQ_ + n * 64) * 1024 + h * 128 + 32 * sl + e0 + l15;
#pragma unroll
                for (int it = 0; it < 4; ++it)
#pragma unroll
                    for (int j = 0; j < 4; ++j) op[(size_t)(16 * it + 4 * q + j) * 1024] = f2b(ao[it][j]);
            }
        } else {
            const int lt = tid - 256;
            u32x4 r0[15], r1[15];
#define SC_GLOAD(R, nn) do { const size_t chh = (size_t)bh * 64 + (nn); \
                const u32x4* pw = (const u32x4*)(Wg + chh * 8192) + lt; const u32x4* pq = (const u32x4*)(QDg + chh * 8192) + lt; const u32x4* pk = (const u32x4*)(KDTg + chh * 8192) + lt; \
                const u32x4* pqk = (const u32x4*)(QKg + chh * 4096) + lt; \
                _Pragma("unroll") for (int _i = 0; _i < 4; ++_i) { R[_i] = pw[256 * _i]; R[4 + _i] = pq[256 * _i]; R[8 + _i] = pk[256 * _i]; } \
                R[12] = pqk[0]; R[13] = pqk[256]; R[14] = *(const u32x4*)(Ug + chh * 8192 + (lt >> 2) * 128 + 32 * sl + 8 * (lt & 3)); } while (0)
#define SC_LSTORE(R, bufp) do { int ltv = lt; asm volatile("" : "+v"(ltv)); \
                LAS unsigned char* _w = (bufp) + WSo + (ltv >> 4) * 272 + (ltv & 15) * 16; LAS unsigned char* _k = (bufp) + KDTo + (ltv >> 3) * 144 + (ltv & 7) * 16; \
                _Pragma("unroll") for (int _i = 0; _i < 4; ++_i) { *(LAS u32x4*)(_w + 4352 * _i) = R[_i]; *(LAS u32x4*)(_w + (QDo - WSo) + 4352 * _i) = R[4 + _i]; *(LAS u32x4*)(_k + 4608 * _i) = R[8 + _i]; } \
                *(LAS u32x4*)(_k + (QKo - KDTo)) = R[12]; *(LAS u32x4*)(_k + (QKo - KDTo) + 4608) = R[13]; *(LAS u32x4*)((bufp) + USo + ltv * 16) = R[14]; } while (0)
            SC_GLOAD(r0, 0);
            SC_LSTORE(r0, lds);
            SC_GLOAD(r0, 1);
            SC_GLOAD(r1, 2);
            for (int n = 0; n < 64; n += 2) {
                __syncthreads();
                SC_LSTORE(r0, lds + BUF);
                SC_GLOAD(r0, (n + 3 < 64 ? n + 3 : 63));
                __syncthreads();
                __syncthreads();
                if (n + 2 < 64) SC_LSTORE(r1, lds);
                SC_GLOAD(r1, (n + 4 < 64 ? n + 4 : 63));
                __syncthreads();
            }
#undef SC_GLOAD
#undef SC_LSTORE
        }
        __syncthreads();
    }
}

__device__ __forceinline__ void phase_mix_out(const Args& a, const int wave_s) {
    TID_SETUP; const int gw = blockIdx.x * 8 + wave, NGW = gridDim.x * 8, gt = blockIdx.x * 512 + tid, NGT = gridDim.x * 512;
    unsigned char* ws = a.ws;
    const bf16_t* proj = (const bf16_t*)(ws + WS_PROJ); const bf16_t* Og = (const bf16_t*)(ws + WS_O); bf16_t* ycat = (bf16_t*)(ws + WS_YCAT);
    const float* dng = a.in[8]; const float* caw = a.in[4];
    {
        const int sub = lane >> 4, c8 = (lane & 15) * 8;
        const f32x4 g0 = *(const f32x4*)(dng + c8), g1 = *(const f32x4*)(dng + c8 + 4);
        constexpr int NIT = T_ * 8 / 4;
        for (int it0 = gw; it0 < NIT; it0 += 4 * NGW) {
            u32x4 ov[4], zv[4];
#pragma unroll
            for (int k = 0; k < 4; ++k) { const int it = it0 + k * NGW; if (it < NIT) { const int pair = it * 4 + sub, t = pair >> 3, h = pair & 7;
                ov[k] = *(const u32x4*)(Og + (size_t)t * 1024 + h * 128 + c8); zv[k] = *(const u32x4*)(proj + (size_t)t * NPROJ + 6144 + h * 128 + c8); } }
#pragma unroll
            for (int k = 0; k < 4; ++k) { const int it = it0 + k * NGW; if (it < NIT) { const int pair = it * 4 + sub, t = pair >> 3, h = pair & 7;
                float o[8] = {blo(ov[k].x), bhi(ov[k].x), blo(ov[k].y), bhi(ov[k].y), blo(ov[k].z), bhi(ov[k].z), blo(ov[k].w), bhi(ov[k].w)};
                const float z[8] = {blo(zv[k].x), bhi(zv[k].x), blo(zv[k].y), bhi(zv[k].y), blo(zv[k].z), bhi(zv[k].z), blo(zv[k].w), bhi(zv[k].w)};
                float ss = 0.f;
#pragma unroll
                for (int e = 0; e < 8; ++e) ss += o[e] * o[e];
                ss += __shfl_xor(ss, 1); ss += __shfl_xor(ss, 2); ss += __shfl_xor(ss, 4); ss += __shfl_xor(ss, 8);
                const float rs = rsqrtf(ss * (1.f / HD) + EPS_);
#pragma unroll
                for (int e = 0; e < 8; ++e) o[e] = o[e] * rs * (e < 4 ? g0[e & 3] : g1[e & 3]) * silu_f(z[e]);
                u32x4 w; w.x = pk2(o[0], o[1]); w.y = pk2(o[2], o[3]); w.z = pk2(o[4], o[5]); w.w = pk2(o[6], o[7]);
                *(u32x4*)(ycat + (size_t)t * D_ + 1024 + h * 128 + c8) = w; } }
        }
    }
    {
        for (int i = gt; i < T_ * 128; i += NGT) {
            const int t = i >> 7, c8 = (i & 127) * 8, s = t & (SEQ_ - 1);
            float accv[8] = {0.f, 0.f, 0.f, 0.f, 0.f, 0.f, 0.f, 0.f};
#pragma unroll
            for (int j = 0; j < 3; ++j) {
                if (s - 2 + j >= 0) {
                    const bf16_t* rp = proj + (size_t)(t - 2 + j) * NPROJ + c8;
                    const u32x4 xv = *(const u32x4*)(rp), cv = *(const u32x4*)(rp + 2048);
                    const f32x4 w0 = *(const f32x4*)(caw + j * 1024 + c8), w1 = *(const f32x4*)(caw + j * 1024 + c8 + 4);
                    accv[0] += w0[0] * blo(xv.x) * blo(cv.x); accv[1] += w0[1] * bhi(xv.x) * bhi(cv.x); accv[2] += w0[2] * blo(xv.y) * blo(cv.y); accv[3] += w0[3] * bhi(xv.y) * bhi(cv.y);
                    accv[4] += w1[0] * blo(xv.z) * blo(cv.z); accv[5] += w1[1] * bhi(xv.z) * bhi(cv.z); accv[6] += w1[2] * blo(xv.w) * blo(cv.w); accv[7] += w1[3] * bhi(xv.w) * bhi(cv.w);
                }
            }
            const u32x4 bv = *(const u32x4*)(proj + (size_t)t * NPROJ + 1024 + c8);
            u32x4 w; w.x = pk2(accv[0] * blo(bv.x), accv[1] * bhi(bv.x)); w.y = pk2(accv[2] * blo(bv.y), accv[3] * bhi(bv.y));
            w.z = pk2(accv[4] * blo(bv.z), accv[5] * bhi(bv.z)); w.w = pk2(accv[6] * blo(bv.w), accv[7] * bhi(bv.w));
            *(u32x4*)(ycat + (size_t)t * D_ + c8) = w;
        }
    }
}

__device__ __forceinline__ void phase_fixup(const Args& a, const int wave_s) {
    TID_SETUP; const int gt = blockIdx.x * 512 + tid, NGT = gridDim.x * 512;
    unsigned char* ws = a.ws; const float* edge = (const float*)(ws + WS_EDGE); bf16_t* act = (bf16_t*)(ws + WS_ACT); const float* cw = a.in[12];
    for (int i = gt; i < 256 * 2 * 1408; i += NGT) {
        const int cq = i % 1408, rr = (i / 1408) & 1, G = i / 2816;
        const int c = 4 * cq, np = (c >> 7) * 256 + (c & 127);
        f32x4 y[2];
#pragma unroll
        for (int gv = 0; gv < 2; ++gv) {
            const int off = gv * 128, wcol = gv * DFF + c;
            f32x4 em2 = (f32x4){0.f, 0.f, 0.f, 0.f}, em1 = em2;
            if ((G & 63) != 0) { em2 = *(const f32x4*)(edge + ((size_t)(G - 1) * 4 + 0) * NUP + np + off); em1 = *(const f32x4*)(edge + ((size_t)(G - 1) * 4 + 1) * NUP + np + off); }
            const f32x4 e0 = *(const f32x4*)(edge + ((size_t)G * 4 + 2) * NUP + np + off), e1 = *(const f32x4*)(edge + ((size_t)G * 4 + 3) * NUP + np + off);
            const f32x4 w0 = *(const f32x4*)(cw + wcol), w1 = *(const f32x4*)(cw + NUP + wcol), w2 = *(const f32x4*)(cw + 2 * NUP + wcol);
            y[gv] = rr == 0 ? (w0 * em2 + w1 * em1 + w2 * e0) : (w0 * em1 + w1 * e0 + w2 * e1);
        }
        u32x2 w; w.x = pk2(silu_f(y[0][0]) * y[1][0], silu_f(y[0][1]) * y[1][1]); w.y = pk2(silu_f(y[0][2]) * y[1][2], silu_f(y[0][3]) * y[1][3]);
        *(u32x2*)(act + (size_t)(64 * G + rr) * DFF + c) = w;
    }
}
__device__ __forceinline__ void phase_final(const Args& a, const int wave_s) {
    TID_SETUP; const int gt = blockIdx.x * 512 + tid, NGT = gridDim.x * 512;
    const float* rss3 = (const float*)(a.ws + WS_RSS) + 2 * T_; const f32x4* g4 = (const f32x4*)a.in[17]; f32x4* o4 = (f32x4*)a.out; const u32x2* x3 = (const u32x2*)(a.ws + WS_X3B);
    constexpr int N4 = T_ * D_ / 4;
    for (int i0 = gt; i0 < N4; i0 += 4 * NGT) {
        u32x2 xw[4]; float ssv[4]; f32x4 gv[4];
#pragma unroll
        for (int k = 0; k < 4; ++k) { const int i = i0 + k * NGT; if (i < N4) { xw[k] = __builtin_nontemporal_load(&x3[i]); ssv[k] = rss3[i >> 9]; gv[k] = g4[i & 511]; } }
#pragma unroll
        for (int k = 0; k < 4; ++k) { const int i = i0 + k * NGT; if (i < N4) { const float rs = rsqrtf(ssv[k] * (1.f / D_) + EPS_); const f32x4 g = gv[k];
            f32x4 v; v[0] = blo(xw[k].x) * rs * g[0]; v[1] = bhi(xw[k].x) * rs * g[1]; v[2] = blo(xw[k].y) * rs * g[2]; v[3] = bhi(xw[k].y) * rs * g[3]; __builtin_nontemporal_store(v, &o4[i]); } }
    }
}

__global__ void __launch_bounds__(512) mega(Args a) {
    extern __shared__ __attribute__((aligned(16))) unsigned char lds_raw[];
    LAS unsigned char* lds = (LAS unsigned char*)lds_raw;
    cg::grid_group grid = cg::this_grid();
    const int wave_s = __builtin_amdgcn_readfirstlane((int)(threadIdx.x >> 6));
    unsigned char* ws = a.ws;
    float* rss = (float*)(ws + WS_RSS);
    unsigned* barw = (unsigned*)(ws + WS_BAR);
    volatile LAS unsigned* xst = (volatile LAS unsigned*)(lds + LDS_BYTES - 16);
    if (wave_s == 0) { const int l0 = lane_opaque(); if (l0 < 4) xst[l0] = 0u; }
    __syncthreads();
    if (wave_s == 0 && lane_opaque() == 0) (void)xb_add(&barw[XB_XCNT(xb_xcc_id())], 1u);
    if (a.ph_hi > 1000) grid.sync();
#define GRID_BAR() xcd_barrier(barw, xst, wave_s == 0 && lane_opaque() == 0)
#ifndef DUP_MASK
#define DUP_MASK 0
#endif
#define PH(i, body) if (a.ph_lo <= (i) && (i) < a.ph_hi) { if ((DUP_MASK >> (i)) & 1) { body; GRID_BAR(); } body; if ((i) + 1 < a.ph_hi) GRID_BAR(); }
    PH(0, phase0(a, lds, wave_s));
    PH(1, phase1(a, lds, wave_s));
    PH(2, phase_chunk(a, lds, wave_s));
    PH(3, phase_scan(a, lds, wave_s));
    PH(4, phase_mix_out(a, wave_s));
    PH(5, { EpiResidual<false> E; E.resf = a.in[0]; E.resb = nullptr; E.outb = (bf16_t*)(ws + WS_X1B); E.rss = rss;
            run_gemm(lds, (const bf16_t*)(ws + WS_YCAT), (const bf16_t*)(ws + WS_WOUT), T_, D_, D_, E, wave_s); });
    PH(6, { EpiUp E; E.act = (bf16_t*)(ws + WS_ACT); E.edge = (float*)(ws + WS_EDGE); E.rss = rss; E.cw = a.in[12];
            run_gemm(lds, (const bf16_t*)(ws + WS_X1B), (const bf16_t*)(ws + WS_WUP), T_, NUP, D_, E, wave_s); });
    PH(7, phase_fixup(a, wave_s));
    PH(8, { EpiResidual<true> E; E.resf = nullptr; E.resb = (const bf16_t*)(ws + WS_X1B); E.outb = (bf16_t*)(ws + WS_X1B); E.rss = rss + T_;
            run_gemm(lds, (const bf16_t*)(ws + WS_ACT), (const bf16_t*)(ws + WS_WDOWN), T_, D_, DFF, E, wave_s); });
    PH(9, { EpiPle E; E.x2b = (const bf16_t*)(ws + WS_X1B); E.x3b = (bf16_t*)(ws + WS_X3B); E.pp = (const bf16_t*)a.out; E.rss2 = rss + T_; E.rss3 = rss + 2 * T_;
            run_gemm(lds, (const bf16_t*)(ws + WS_X1B), (const bf16_t*)(ws + WS_WPG), T_, D_, D_, E, wave_s); });
    PH(10, phase_final(a, wave_s));
#undef PH
}

extern "C" void kernel_launch(void* const* d_in, const int* in_sizes, int n_in, void* d_out, int out_size, void* d_ws, size_t ws_size, hipStream_t stream) {
    static int grid = 0;
    if (grid == 0) {
        if (n_in != 18 || in_sizes[0] != T_ * D_ || out_size != T_ * D_ || ws_size < WS_END) { fprintf(stderr, "kernel_launch: unexpected shapes (n_in %d, ws %zu, need %zu)\n", n_in, ws_size, (size_t)WS_END); grid = -1; return; }
        int dev = 0, cus = 0, per_cu = 0;
        if (hipGetDevice(&dev) != hipSuccess || hipDeviceGetAttribute(&cus, hipDeviceAttributeMultiprocessorCount, dev) != hipSuccess) { grid = -1; return; }
        if (hipFuncSetAttribute((const void*)mega, hipFuncAttributeMaxDynamicSharedMemorySize, LDS_BYTES) != hipSuccess) { fprintf(stderr, "kernel_launch: hipFuncSetAttribute failed\n"); grid = -1; return; }
        if (hipOccupancyMaxActiveBlocksPerMultiprocessor(&per_cu, (const void*)mega, 512, LDS_BYTES) != hipSuccess || per_cu < 1) { fprintf(stderr, "kernel_launch: occupancy query says %d blocks per CU\n", per_cu); per_cu = 1; }
        (void)hipGetLastError();
        grid = cus;
    }
    if (grid < 0) return;
    Args a{};
    for (int i = 0; i < 18; ++i) a.in[i] = (const float*)d_in[i];
    a.out = (float*)d_out; a.ws = (unsigned char*)d_ws; a.ph_lo = 0; a.ph_hi = NPHASE;
    if (hipMemsetAsync((char*)d_ws + WS_BAR, 0, (size_t)XCD_BAR_WORDS * 4, stream) != hipSuccess) { fprintf(stderr, "kernel_launch: memset of the barrier words failed\n"); return; }
    void* args[] = {&a};
    hipError_t e = hipLaunchCooperativeKernel((const void*)mega, dim3(grid), dim3(512), args, LDS_BYTES, stream);
    if (e != hipSuccess) fprintf(stderr, "kernel_launch: cooperative launch failed: %s (grid %d)\n", hipGetErrorString(e), grid);
}
```
